# Optimizing an MI355X kernel written in HIP

```python
import jax, jax.numpy as jnp
from jax import lax
import numpy as np

D_MODEL = 1024
BATCH = 8
SEQ = 4096
DEPTH = 4

MIX_WIDTH = D_MODEL
POOL_WINDOWS = (2, 4, 8, 16)
N_POOL_GROUPS = 4
POOL_WIDTH = D_MODEL // 4
POOL_GROUP = POOL_WIDTH // N_POOL_GROUPS
CONV_WIDTH = D_MODEL // 4
CONV_HEADS = 4
CONV_K = 3
HEAD_DIM = 64
N_Q_HEADS = (D_MODEL // 2) // HEAD_DIM
N_KV_HEADS = 2
GQA_GROUP = N_Q_HEADS // N_KV_HEADS
Q_WIDTH = N_Q_HEADS * HEAD_DIM
KV_WIDTH = N_KV_HEADS * HEAD_DIM
WINDOW = 128
BLOCK = 128
IN_SIZES = (POOL_WIDTH, CONV_WIDTH, CONV_WIDTH, CONV_WIDTH, Q_WIDTH, KV_WIDTH, KV_WIDTH)
IN_WIDTH = POOL_WIDTH + 3 * CONV_WIDTH + Q_WIDTH + 2 * KV_WIDTH
D_FF = 2816
EPS = 1e-6
NEG_INF = -1e30

kernel_name = "hybrid_pool_conv_swa_sink_block"


def rms_norm(x, g):
    xf = x.astype(jnp.float32)
    y = xf * lax.rsqrt(jnp.mean(xf * xf, axis=-1, keepdims=True) + EPS)
    return (y * g.astype(jnp.float32)).astype(x.dtype)


def causal_dwconv(u, w):
    k = w.shape[0]
    s = u.shape[1]
    up = jnp.pad(u, ((0, 0), (k - 1, 0), (0, 0)))
    y = up[:, 0:s, :] * w[0]
    for j in range(1, k):
        y = y + up[:, j:j + s, :] * w[j]
    return y


def pool_mixer(u, w_grp, scale):
    bn, s, _ = u.shape
    uf = u.astype(jnp.float32)
    cs = jnp.pad(jnp.cumsum(uf, axis=1), ((0, 0), (1, 0), (0, 0)))
    cnt_base = jnp.arange(1, s + 1, dtype=jnp.int32)
    outs = []
    for g, w in enumerate(POOL_WINDOWS):
        c = cs[:, :, g * POOL_GROUP:(g + 1) * POOL_GROUP]
        lagged = jnp.pad(c, ((0, 0), (w - 1, 0), (0, 0)))[:, :s, :]
        cnt = jnp.minimum(cnt_base, w).astype(jnp.float32)
        mean = (c[:, 1:, :] - lagged) / cnt[None, :, None]
        outs.append(mean - uf[:, :, g * POOL_GROUP:(g + 1) * POOL_GROUP])
    d = jnp.stack(outs, axis=2)
    y = jnp.einsum('bsgc,gcd->bsgd', d, w_grp.astype(jnp.float32)).reshape(bn, s, POOL_WIDTH)
    return (y * scale.astype(jnp.float32)).astype(u.dtype)


def swa_sink_attention(q, k, v, sinks):
    bn, s, _ = q.shape
    nb = s // BLOCK
    qb = q.reshape(bn, nb, BLOCK, N_KV_HEADS, GQA_GROUP, HEAD_DIM)
    kb = k.reshape(bn, nb, BLOCK, N_KV_HEADS, HEAD_DIM)
    vb = v.reshape(bn, nb, BLOCK, N_KV_HEADS, HEAD_DIM)
    pad = ((0, 0), (1, 0), (0, 0), (0, 0), (0, 0))
    kk = jnp.concatenate([jnp.pad(kb, pad)[:, :nb], kb], axis=2)
    vv = jnp.concatenate([jnp.pad(vb, pad)[:, :nb], vb], axis=2)
    scores = jnp.einsum('bnqhgd,bnkhd->bnhgqk', qb, kk,
                        preferred_element_type=jnp.float32) * (HEAD_DIM ** -0.5)
    blk = jnp.arange(nb, dtype=jnp.int32)[:, None, None] * BLOCK
    qpos = blk + jnp.arange(BLOCK, dtype=jnp.int32)[None, :, None]
    kpos = blk - BLOCK + jnp.arange(2 * BLOCK, dtype=jnp.int32)[None, None, :]
    diff = qpos - kpos
    mask = (diff >= 0) & (diff < WINDOW) & (kpos >= 0)
    scores = jnp.where(mask[None, :, None, None, :, :], scores, NEG_INF)
    sink = jnp.broadcast_to(
        sinks.astype(jnp.float32).reshape(1, 1, N_KV_HEADS, GQA_GROUP, 1, 1),
        scores.shape[:-1] + (1,))
    probs = jax.nn.softmax(jnp.concatenate([scores, sink], axis=-1), axis=-1)[..., :2 * BLOCK]
    out = jnp.einsum('bnhgqk,bnkhd->bnqhgd', probs.astype(vv.dtype), vv)
    return out.reshape(bn, s, Q_WIDTH)


def setup_inputs(seed: int = 0) -> dict:
    key = jax.random.key(seed)
    ks = jax.random.split(key, 16)
    f32 = jnp.float32

    def nrm(k, shape, scale):
        return jax.random.normal(k, shape, f32) * scale

    def gain(k, width):
        return 1.0 + 0.1 * jax.random.normal(k, (DEPTH, width), f32)

    return {
        "x": nrm(ks[0], (BATCH, SEQ, D_MODEL), 1.0),
        "norm_mix_pre": gain(ks[1], D_MODEL),
        "w_in": nrm(ks[2], (DEPTH, D_MODEL, IN_WIDTH), D_MODEL ** -0.5),
        "pool_w": nrm(ks[3], (DEPTH, N_POOL_GROUPS, POOL_GROUP, POOL_GROUP), POOL_GROUP ** -0.5),
        "pool_scale": gain(ks[4], POOL_WIDTH),
        "conv_w": nrm(ks[5], (DEPTH, CONV_K, CONV_WIDTH), CONV_K ** -0.5),
        "attn_sinks": nrm(ks[6], (DEPTH, N_Q_HEADS), 0.5),
        "w_o": nrm(ks[7], (DEPTH, MIX_WIDTH, D_MODEL), MIX_WIDTH ** -0.5),
        "norm_mix_post": gain(ks[8], D_MODEL),
        "norm_ffn_pre": gain(ks[9], D_MODEL),
        "ffn_w_up": nrm(ks[10], (DEPTH, D_MODEL, 2 * D_FF), D_MODEL ** -0.5),
        "ffn_conv_w": nrm(ks[11], (DEPTH, CONV_K, 2 * D_FF), CONV_K ** -0.5),
        "ffn_conv_b": nrm(ks[12], (DEPTH, 2 * D_FF), 0.02),
        "ffn_w_down": nrm(ks[13], (DEPTH, D_FF, D_MODEL), D_FF ** -0.5),
        "norm_ffn_post": gain(ks[14], D_MODEL),
    }


def reference(x, norm_mix_pre, w_in, pool_w, pool_scale, conv_w, attn_sinks, w_o,
              norm_mix_post, norm_ffn_pre, ffn_w_up, ffn_conv_w, ffn_conv_b, ffn_w_down,
              norm_ffn_post):
    offsets = []
    acc = 0
    for sz in IN_SIZES[:-1]:
        acc += sz
        offsets.append(acc)
    for l in range(DEPTH):
        h = rms_norm(x, norm_mix_pre[l])
        proj = jnp.einsum('bsd,de->bse', h, w_in[l])
        u_pool, g_b, g_c, u_conv, q, k, v = jnp.split(proj, offsets, axis=-1)
        y_pool = pool_mixer(u_pool, pool_w[l], pool_scale[l])
        y_conv = g_b * causal_dwconv(g_c * u_conv, conv_w[l])
        y_attn = swa_sink_attention(q, k, v, attn_sinks[l])
        mix = jnp.einsum('bse,ed->bsd', jnp.concatenate([y_pool, y_conv, y_attn], axis=-1), w_o[l])
        x = x + rms_norm(mix, norm_mix_post[l])
        h = rms_norm(x, norm_ffn_pre[l])
        up = causal_dwconv(jnp.einsum('bsd,df->bsf', h, ffn_w_up[l]), ffn_conv_w[l]) + ffn_conv_b[l]
        gate, val = jnp.split(up, 2, axis=-1)
        ff = jnp.einsum('bsf,fd->bsd', jax.nn.silu(gate) * val, ffn_w_down[l])
        x = x + rms_norm(ff, norm_ffn_post[l])
    return x
```

```cpp
#include <hip/hip_runtime.h>
#include <hip/hip_cooperative_groups.h>
#include <cstdio>
#include <cstdint>
namespace cg = cooperative_groups;
namespace pg8 {
#define PG8_LAS __attribute__((address_space(3)))
typedef unsigned short bf16_t;
typedef short bf16x8 __attribute__((ext_vector_type(8)));
typedef float f32x4 __attribute__((ext_vector_type(4)));
typedef unsigned u32x4 __attribute__((ext_vector_type(4)));
constexpr int BM = 256, BK = 64, HALF = 128, HTB = HALF * BK * 2  , STAGE_BYTES = 8 * HTB, NXCD = 8, WGM = 8;

__host__ __device__ __forceinline__ int lds_byte(int r, int c) { const int st = (r >> 4) * 2 + (c >> 5), rr = r & 15, cc = c & 31, ob = rr * 64 + cc * 2; return st * 1024 + (ob ^ (((ob >> 9) & 1) << 5)); }
__host__ __device__ __forceinline__ void stage_rc(int b, int& R, int& C) { const int st = b / 1024, sb = b % 1024, swz = sb ^ (((sb >> 9) & 1) << 5); R = (st >> 1) * 16 + swz / 64; C = (st & 1) * 32 + (swz % 64) / 2; }
__host__ __device__ __forceinline__ int perm32(int rho) { const int n = rho >> 4, i = rho & 15; return 8 * (i >> 2) + 4 * n + (i & 3); }

struct Unit { int pm, pn; };
struct Gemm { const bf16_t* A; const bf16_t* Bt; int M, N, K; };

struct StaticOrder {
    int nM, nN, nwg, G, c;
    __host__ __device__ void init(int M, int N, int G_, int c_) { nM = M / BM; nN = N / BM; nwg = nM * nN; G = G_; c = c_; }
    __host__ __device__ bool next(int i, Unit& u) const {
        const long L = (long)i * G + c; if (L >= nwg) return false;
        int wgid = (int)L; { const int q = nwg / NXCD, r = nwg % NXCD, xcd = wgid % NXCD, off = wgid / NXCD; wgid = (xcd < r ? xcd * (q + 1) : r * (q + 1) + (xcd - r) * q) + off; }
        const int nig = WGM * nN, gid = wgid / nig, fm = gid * WGM, gsz = (nM - fm) < WGM ? (nM - fm) : WGM;
        u.pm = fm + ((wgid % nig) % gsz); u.pn = (wgid % nig) / gsz; return true;
    }
    __device__ __forceinline__ void a_ready(const Unit&) const {}
    __device__ __forceinline__ void done(const Unit&) const {}
};

__device__ __forceinline__ unsigned cvt_pk_bf16(float lo, float hi) { unsigned r; asm volatile("v_cvt_pk_bf16_f32 %0, %1, %2" : "=v"(r) : "v"(lo), "v"(hi)); return r; }
typedef float f32x2 __attribute__((ext_vector_type(2)));
typedef unsigned u32x2 __attribute__((ext_vector_type(2)));
struct EpiBf16 {
    static constexpr bool PERM = true, AFTER_DRAIN = false;
    bf16_t* O; int ldc;
    __device__ __forceinline__ void operator()(const f32x4 (&acc)[2][2][4][2], const Unit& u, int wr, int wc, int fr, int fq) const {
        const int row0 = u.pm * BM + wr * 64 + fr; const int col0 = u.pn * BM + wc * 32 + 8 * fq;
#pragma unroll
        for (int ai = 0; ai < 2; ++ai)
#pragma unroll
            for (int m = 0; m < 4; ++m) { bf16_t* rowp = O + (size_t)(row0 + ai * HALF + m * 16) * ldc + col0;
#pragma unroll
                for (int bj = 0; bj < 2; ++bj) { const f32x4 v0 = acc[ai][bj][m][0], v1 = acc[ai][bj][m][1];
                    u32x4 w; w.x = cvt_pk_bf16(v0[0], v0[1]); w.y = cvt_pk_bf16(v0[2], v0[3]); w.z = cvt_pk_bf16(v1[0], v1[1]); w.w = cvt_pk_bf16(v1[2], v1[3]);
                    *(u32x4*)(rowp + bj * HALF) = w; } }
    }
};

#ifndef ROT_DPP
#define ROT_DPP 0
#endif
__device__ __forceinline__ float rot_lane(float v, int src) {
    return __shfl(v, src, 64);
}
struct EpiUpConv {
    static constexpr bool PERM = true, AFTER_DRAIN = false;
    static constexpr int FF = 2816, UPW = 5632;
    bf16_t* H; const float* cw; const float* cb; float* head; float* tail; PG8_LAS float* bnd;
    __device__ __forceinline__ void operator()(const f32x4 (&acc)[2][2][4][2], const Unit& u, int wr, int wc, int fr, int fq) const {
        const int lane = fr + 16 * fq;
        const int xcol = wc * 32 + 8 * fq;
        const int fcol = u.pn * 128 + xcol;
        if (fr >= 14) {
#pragma unroll
            for (int ai = 0; ai < 2; ++ai)
#pragma unroll
                for (int bj = 0; bj < 2; ++bj)
#pragma unroll
                    for (int n = 0; n < 2; ++n) *(PG8_LAS f32x4*)(bnd + ((2 * ai + wr) * 2 + (fr - 14)) * 256 + bj * 128 + xcol + 4 * n) = acc[ai][bj][3][n];
        }
        if (wr == 0 && fr < 2) {
#pragma unroll
            for (int bj = 0; bj < 2; ++bj)
#pragma unroll
                for (int n = 0; n < 2; ++n) *(f32x4*)(head + ((size_t)u.pm * 2 + fr) * UPW + bj * FF + fcol + 4 * n) = acc[0][bj][0][n];
        }
        if (wr == 1 && fr >= 14) {
#pragma unroll
            for (int bj = 0; bj < 2; ++bj)
#pragma unroll
                for (int n = 0; n < 2; ++n) *(f32x4*)(tail + ((size_t)u.pm * 2 + (fr - 14)) * UPW + bj * FF + fcol + 4 * n) = acc[1][bj][3][n];
        }
        asm volatile("s_waitcnt lgkmcnt(0)" ::: "memory"); __builtin_amdgcn_s_barrier(); asm volatile("" ::: "memory");
        const int src1 = (lane & 48) | ((fr + 15) & 15), src2 = (lane & 48) | ((fr + 14) & 15);
        u32x2 pk0[2][4];
#pragma unroll
        for (int n = 0; n < 2; ++n) {
            f32x4 w0[2], w1[2], w2[2], bb[2];
#pragma unroll
            for (int bj = 0; bj < 2; ++bj) { const int c = bj * FF + fcol + 4 * n;
                w0[bj] = *(const f32x4*)(cw + c); w1[bj] = *(const f32x4*)(cw + UPW + c); w2[bj] = *(const f32x4*)(cw + 2 * UPW + c); bb[bj] = *(const f32x4*)(cb + c); }
#pragma unroll
            for (int ai = 0; ai < 2; ++ai) {
                const int blk = 2 * ai + wr;
                f32x4 y[2][4];
#pragma unroll
                for (int bj = 0; bj < 2; ++bj) {
                    f32x4 pr1 = (f32x4){0.f, 0.f, 0.f, 0.f}, pr2 = (f32x4){0.f, 0.f, 0.f, 0.f};
                    if (blk > 0) {
                        pr1 = *(const PG8_LAS f32x4*)(bnd + ((blk - 1) * 2 + 1) * 256 + bj * 128 + xcol + 4 * n);
                        pr2 = *(const PG8_LAS f32x4*)(bnd + ((blk - 1) * 2 + (fr == 0 ? 0 : 1)) * 256 + bj * 128 + xcol + 4 * n);
                    }
#pragma unroll
                    for (int m = 0; m < 4; ++m) {
                        const f32x4 cur = acc[ai][bj][m][n]; f32x4 r1, r2;
#pragma unroll
                        for (int j = 0; j < 4; ++j) { r1[j] = rot_lane(cur[j], src1); r2[j] = rot_lane(cur[j], src2); }
                        const f32x4 p1 = fr >= 1 ? r1 : pr1, p2 = fr >= 2 ? r2 : pr2;
                        y[bj][m] = w2[bj] * cur + w1[bj] * p1 + w0[bj] * p2 + bb[bj];
                        pr1 = r1; pr2 = r2;
                    }
                }
#pragma unroll
                for (int m = 0; m < 4; ++m) {
                    f32x4 hv;
#pragma unroll
                    for (int j = 0; j < 4; ++j) { const float g = y[0][m][j]; hv[j] = g * __builtin_amdgcn_rcpf(1.0f + __builtin_amdgcn_exp2f(-1.4426950408889634f * g)) * y[1][m][j]; }
                    if (n == 0) { pk0[ai][m].x = cvt_pk_bf16(hv[0], hv[1]); pk0[ai][m].y = cvt_pk_bf16(hv[2], hv[3]); }
                    else { u32x4 w; w.x = pk0[ai][m].x; w.y = pk0[ai][m].y; w.z = cvt_pk_bf16(hv[0], hv[1]); w.w = cvt_pk_bf16(hv[2], hv[3]);
                        const int row = u.pm * BM + ai * HALF + wr * 64 + m * 16 + fr;
                        *(u32x4*)(H + (size_t)row * FF + fcol) = w; }
                }
            }
        }
    }
};

template <class Epi, class Sched, bool ALIGN_EPI = false, bool SP2 = false>
__device__ __forceinline__ void gemm_phase(PG8_LAS unsigned char* lds, const Gemm g, const Sched& S, const Epi& E, const int tid) {
    const int wid = __builtin_amdgcn_readfirstlane(tid >> 6), lane = tid & 63, wr = wid >> 2, wc = wid & 3, fr = lane & 15, fq = lane >> 4;
    const int K = g.K, nt = K / BK;
    unsigned voffA[2], voffB[2];
#pragma unroll
    for (int i = 0; i < 2; ++i) { int R, C; stage_rc(tid * 16 + i * 8192, R, C); const int Rb = Epi::PERM ? ((R & ~31) + perm32(R & 31)) : R;
        voffA[i] = (unsigned)(R * K + C) * 2u; voffB[i] = (unsigned)(Rb * K + C) * 2u; }
    const size_t kstep = (size_t)(BK * 2);
    const size_t hstep = (size_t)HALF * K * 2;
    const size_t tstep = 2 * hstep;
    const unsigned ldsw = (unsigned)wid * 1024u;
    const int aoff = lds_byte(wr * 64 + fr, fq * 8), boff = lds_byte(wc * 32 + fr, fq * 8);
#define PG8_SA(b, h) (((b) * 2 + (h)) * HTB)
#define PG8_SB(b, h) ((4 + (b) * 2 + (h)) * HTB)
#define PG8_STAGE(bufoff, gbase, voff) do { _Pragma("unroll") for (int _i = 0; _i < 2; ++_i) \
        __builtin_amdgcn_global_load_lds((const unsigned*)((const char*)(gbase) + (voff)[_i]), (PG8_LAS unsigned*)(lds + (bufoff) + ldsw + _i * 8192), 16, 0, 0); } while (0)
#define PG8_LDA(dst, b, h) do { _Pragma("unroll") for (int m = 0; m < 4; ++m) _Pragma("unroll") for (int k = 0; k < 2; ++k) dst[m][k] = *(const PG8_LAS bf16x8*)(lds + PG8_SA(b, h) + aoff + m * 2048 + k * 1024); } while (0)
#define PG8_LDB(dst, b, h) do { _Pragma("unroll") for (int n = 0; n < 2; ++n) _Pragma("unroll") for (int k = 0; k < 2; ++k) dst[n][k] = *(const PG8_LAS bf16x8*)(lds + PG8_SB(b, h) + boff + n * 2048 + k * 1024); } while (0)
#define PG8_MMA(ai, bj, At, Bt) do { __builtin_amdgcn_s_setprio(1); _Pragma("unroll") for (int m = 0; m < 4; ++m) _Pragma("unroll") for (int n = 0; n < 2; ++n) _Pragma("unroll") for (int k = 0; k < 2; ++k) \
        acc[ai][bj][m][n] = __builtin_amdgcn_mfma_f32_16x16x32_bf16(Bt[n][k], At[m][k], acc[ai][bj][m][n], 0, 0, 0); __builtin_amdgcn_s_setprio(0); } while (0)
#define PG8_WAIT_V(n) asm volatile("s_waitcnt vmcnt(" #n ")" ::: "memory")
#define PG8_WAIT_L(n) asm volatile("s_waitcnt lgkmcnt(" #n ")" ::: "memory")
#define PG8_BAR __builtin_amdgcn_s_barrier()
#define PG8_SCHED __builtin_amdgcn_sched_barrier(0)
    Unit cur, nxt; int ui = 0;
    if (!S.next(0, cur)) return;
    f32x4 acc[2][2][4][2];
#pragma unroll
    for (int a = 0; a < 2; ++a)
#pragma unroll
        for (int b = 0; b < 2; ++b)
#pragma unroll
            for (int m = 0; m < 4; ++m)
#pragma unroll
                for (int n = 0; n < 2; ++n) acc[a][b][m][n] = (f32x4){0.f, 0.f, 0.f, 0.f};
    bf16x8 At[4][2], B0[2][2], B1[2][2];
    const char* cA = (const char*)g.A + (size_t)cur.pm * tstep; const char* cB = (const char*)g.Bt + (size_t)cur.pn * tstep;
    S.a_ready(cur);
    if constexpr (SP2) {
        PG8_STAGE(PG8_SB(0, 0), cB, voffB); PG8_STAGE(PG8_SB(0, 1), cB + hstep, voffB); PG8_STAGE(PG8_SA(0, 0), cA, voffA); PG8_STAGE(PG8_SA(0, 1), cA + hstep, voffA);
        if (wr == 1) PG8_BAR;
        PG8_WAIT_V(2); PG8_BAR;
        PG8_STAGE(PG8_SB(1, 0), cB + kstep, voffB); PG8_STAGE(PG8_SA(1, 0), cA + kstep, voffA); PG8_STAGE(PG8_SB(1, 1), cB + hstep + kstep, voffB);
        PG8_WAIT_V(6); PG8_BAR;
    } else {
        PG8_STAGE(PG8_SB(0, 0), cB, voffB); PG8_STAGE(PG8_SA(0, 0), cA, voffA); PG8_STAGE(PG8_SB(0, 1), cB + hstep, voffB); PG8_STAGE(PG8_SA(0, 1), cA + hstep, voffA);
        if (wr == 1) PG8_BAR;
        PG8_WAIT_V(4); PG8_BAR;
        PG8_STAGE(PG8_SB(1, 0), cB + kstep, voffB); PG8_STAGE(PG8_SA(1, 0), cA + kstep, voffA); PG8_STAGE(PG8_SB(1, 1), cB + hstep + kstep, voffB);
        PG8_WAIT_V(6); PG8_BAR;
    }
    for (;;) {
        const bool has_next = S.next(ui + 1, nxt);
        const char* nA = has_next ? (const char*)g.A + (size_t)nxt.pm * tstep : cA; const char* nB = has_next ? (const char*)g.Bt + (size_t)nxt.pn * tstep : cB;
        for (int t = 0; t < nt; t += 2) {
            const bool last = (t == nt - 2);
            const char* a1 = cA + (size_t)(t + 1) * kstep;
            const char* a2 = last ? nA : cA + (size_t)(t + 2) * kstep; const char* b2 = last ? nB : cB + (size_t)(t + 2) * kstep;
            const char* a3 = a2 + kstep; const char* b3 = b2 + kstep;
            if (last && has_next) S.a_ready(nxt);
            if constexpr (SP2) {
            PG8_LDB(B0, 0, 0); PG8_LDB(B1, 0, 1); PG8_SCHED; PG8_LDA(At, 0, 0); PG8_STAGE(PG8_SA(1, 1), a1 + hstep, voffA);
            PG8_WAIT_V(8); PG8_WAIT_L(0); PG8_BAR; PG8_MMA(0, 0, At, B0); PG8_MMA(0, 1, At, B1); PG8_BAR; PG8_SCHED;
            PG8_LDA(At, 0, 1); PG8_STAGE(PG8_SB(0, 0), b2, voffB); PG8_STAGE(PG8_SB(0, 1), b2 + hstep, voffB); PG8_STAGE(PG8_SA(0, 0), a2, voffA);
            PG8_WAIT_V(8); PG8_WAIT_L(0); PG8_BAR; PG8_MMA(1, 0, At, B0); PG8_MMA(1, 1, At, B1); PG8_BAR; PG8_SCHED;
            PG8_LDB(B0, 1, 0); PG8_LDB(B1, 1, 1); PG8_SCHED; PG8_LDA(At, 1, 0); PG8_STAGE(PG8_SA(0, 1), a2 + hstep, voffA);
            PG8_WAIT_V(8); PG8_WAIT_L(0); PG8_BAR; PG8_MMA(0, 0, At, B0); PG8_MMA(0, 1, At, B1); PG8_BAR; PG8_SCHED;
            PG8_LDA(At, 1, 1); PG8_STAGE(PG8_SB(1, 0), b3, voffB); PG8_STAGE(PG8_SB(1, 1), b3 + hstep, voffB); PG8_STAGE(PG8_SA(1, 0), a3, voffA);
            PG8_WAIT_V(8); PG8_WAIT_L(0); PG8_BAR; PG8_MMA(1, 0, At, B0); PG8_MMA(1, 1, At, B1); PG8_BAR; PG8_SCHED;
            } else {
            PG8_LDB(B0, 0, 0); PG8_SCHED; PG8_LDA(At, 0, 0); PG8_STAGE(PG8_SA(1, 1), a1 + hstep, voffA);
            PG8_WAIT_L(8); PG8_BAR; PG8_WAIT_L(0); PG8_MMA(0, 0, At, B0); PG8_BAR; PG8_SCHED;
            PG8_LDB(B1, 0, 1); PG8_STAGE(PG8_SB(0, 0), b2, voffB);
            PG8_BAR; PG8_WAIT_L(0); PG8_MMA(0, 1, At, B1); PG8_BAR;
            PG8_LDA(At, 0, 1); PG8_STAGE(PG8_SA(0, 0), a2, voffA);
            PG8_BAR; PG8_WAIT_L(0); PG8_MMA(1, 0, At, B0); PG8_BAR; PG8_SCHED;
            PG8_STAGE(PG8_SB(0, 1), b2 + hstep, voffB);
            PG8_WAIT_V(6); PG8_BAR; PG8_MMA(1, 1, At, B1); PG8_BAR;
            PG8_LDB(B0, 1, 0); PG8_SCHED; PG8_LDA(At, 1, 0); PG8_STAGE(PG8_SA(0, 1), a2 + hstep, voffA);
            PG8_WAIT_L(8); PG8_BAR; PG8_WAIT_L(0); PG8_MMA(0, 0, At, B0); PG8_BAR; PG8_SCHED;
            PG8_LDB(B1, 1, 1); PG8_STAGE(PG8_SB(1, 0), b3, voffB);
            PG8_BAR; PG8_WAIT_L(0); PG8_MMA(0, 1, At, B1); PG8_BAR;
            PG8_LDA(At, 1, 1); PG8_STAGE(PG8_SA(1, 0), a3, voffA);
            PG8_BAR; PG8_WAIT_L(0); PG8_MMA(1, 0, At, B0); PG8_BAR; PG8_SCHED;
            PG8_STAGE(PG8_SB(1, 1), b3 + hstep, voffB);
            PG8_WAIT_V(6); PG8_BAR; PG8_MMA(1, 1, At, B1); PG8_BAR;
            }
        }
        if constexpr (ALIGN_EPI) { if (wr == 0) PG8_BAR; }
        if constexpr (!Epi::AFTER_DRAIN) { E(acc, cur, wr, wc, fr, fq); S.done(cur); }
        if (!has_next) break;
#pragma unroll
        for (int a = 0; a < 2; ++a)
#pragma unroll
            for (int b = 0; b < 2; ++b)
#pragma unroll
                for (int m = 0; m < 4; ++m)
#pragma unroll
                    for (int n = 0; n < 2; ++n) acc[a][b][m][n] = (f32x4){0.f, 0.f, 0.f, 0.f};
        cur = nxt; cA = nA; cB = nB; ++ui;
        if constexpr (ALIGN_EPI) { if (wr == 1) PG8_BAR; }
    }
    PG8_WAIT_V(0);
    if constexpr (!ALIGN_EPI) { if (wr == 0) PG8_BAR; }
    PG8_BAR;
    if constexpr (Epi::AFTER_DRAIN) { E.fused(acc, cur, wr, wc, fr, fq, lds, wid, lane); S.done(cur); }
#undef PG8_SA
#undef PG8_SB
#undef PG8_STAGE
#undef PG8_LDA
#undef PG8_LDB
#undef PG8_MMA
#undef PG8_WAIT_V
#undef PG8_WAIT_L
#undef PG8_BAR
#undef PG8_SCHED
}
}

constexpr int NWAVES = 8;
constexpr int BATCH = 8, SEQ = 4096, D = 1024, DEPTH = 4, M = BATCH * SEQ;
constexpr int INW = 1792, FF = 2816, UPW = 2 * FF;
constexpr int C_GB = 256, C_GC = 512, C_UC = 768, C_Q = 1024, C_K = 1536, C_V = 1664;
constexpr float EPS = 1e-6f;
constexpr float LOG2E = 1.4426950408889634f;

constexpr size_t MiB = 1u << 20;
constexpr size_t WS_W = 1 * MiB;
constexpr size_t W_LAYER = 22 * MiB, W_IN = 0, W_O = (size_t)INW * D * 2, W_UP = W_O + (size_t)D * D * 2, W_DN = W_UP + (size_t)UPW * D * 2;
static_assert(W_DN + (size_t)D * FF * 2 <= W_LAYER, "weight layer map");
constexpr size_t WS_POOLT = 89 * MiB;
constexpr size_t WS_XN = 90 * MiB;
constexpr size_t WS_PROJ = 154 * MiB;
constexpr size_t WS_MIX = 266 * MiB;
constexpr size_t WS_H = 154 * MiB;
constexpr size_t WS_Y = 330 * MiB;
constexpr size_t WS_HEAD = 394 * MiB, WS_TAIL = 400 * MiB;
constexpr size_t WS_END = 406 * MiB;
static_assert(WS_PROJ + (size_t)M * INW * 2 <= WS_MIX && WS_H + (size_t)M * FF * 2 <= WS_Y && WS_HEAD + (size_t)128 * 2 * UPW * 4 <= WS_TAIL, "d_ws map");

constexpr int RING_BYTES = 131072, BND_OFF = RING_BYTES, LDS_BYTES = 147456;

#define LAS __attribute__((address_space(3)))
typedef unsigned short bf16;
typedef unsigned v4u __attribute__((ext_vector_type(4)));
typedef unsigned v2u __attribute__((ext_vector_type(2)));
typedef float f32x4 __attribute__((ext_vector_type(4)));
typedef float f32x16 __attribute__((ext_vector_type(16)));
typedef short bf16x8 __attribute__((ext_vector_type(8)));
typedef short s16x4 __attribute__((ext_vector_type(4)));
#define LDS_WAIT() asm volatile("s_waitcnt lgkmcnt(0)" ::: "memory")
#define MFMA32(a, b, c) __builtin_amdgcn_mfma_f32_32x32x16_bf16((a), (b), (c), 0, 0, 0)

__device__ __forceinline__ unsigned f2bf(float f) { unsigned u = __builtin_bit_cast(unsigned, f); return (u + 0x7fffu + ((u >> 16) & 1u)) >> 16; }
__device__ __forceinline__ unsigned pk2(float lo, float hi) { return f2bf(lo) | (f2bf(hi) << 16); }
__device__ __forceinline__ float bf_lo(unsigned w) { return __builtin_bit_cast(float, w << 16); }
__device__ __forceinline__ float bf_hi(unsigned w) { return __builtin_bit_cast(float, w & 0xffff0000u); }
__device__ __forceinline__ int crow(int r, int hi) { return (r & 3) + 8 * (r >> 2) + 4 * hi; }
__device__ __forceinline__ float wave_sum(float v) {
#pragma unroll
    for (int o = 1; o < 64; o <<= 1) v += __shfl_xor(v, o);
    return v;
}

struct Frame {
    LAS unsigned char* lds;
    int tid, lane, wave, G, bx;
    const float* in[15]; float* out; unsigned char* ws;
};

__device__ __forceinline__ void p0_item(const float* W, int K, int N, const float* gain, bf16* WT, int mode, LAS float* scr, int item, int lane) {
    const int nblk = N / 32, kb = item / nblk, nb = item % nblk, k0 = 64 * kb, n0 = 32 * nb;
#pragma unroll 8
    for (int i = 0; i < 32; ++i) { const int kk = 2 * i + (lane >> 5); const float gsc = gain ? gain[k0 + kk] : 1.0f; scr[kk * 33 + (lane & 31)] = W[(size_t)(k0 + kk) * N + n0 + (lane & 31)] * gsc; }
    LDS_WAIT(); asm volatile("" ::: "memory");
    int d0 = n0;
    if (mode == 1) { d0 = (n0 < FF) ? 256 * (n0 / 128) + (n0 % 128) : 256 * ((n0 - FF) / 128) + 128 + ((n0 - FF) % 128); }
    const int c = lane & 7;
#pragma unroll
    for (int j = 0; j < 4; ++j) { const int n = (lane >> 3) + 8 * j; const LAS float* s = scr + (8 * c) * 33 + n;
        v4u o; o.x = pk2(s[0 * 33], s[1 * 33]); o.y = pk2(s[2 * 33], s[3 * 33]); o.z = pk2(s[4 * 33], s[5 * 33]); o.w = pk2(s[6 * 33], s[7 * 33]);
        *(v4u*)(WT + (size_t)(d0 + n) * K + k0 + 8 * c) = o; }
    LDS_WAIT(); asm volatile("" ::: "memory");
}

__device__ __forceinline__ void rms_row_to_bf16(int lane, const float* xrow, bf16* orow) {
    const f32x4* xr = (const f32x4*)xrow + lane;
    f32x4 v[4]; float s = 0.f;
#pragma unroll
    for (int j = 0; j < 4; ++j) { v[j] = xr[64 * j]; s += (v[j].x * v[j].x + v[j].y * v[j].y) + (v[j].z * v[j].z + v[j].w * v[j].w); }
    const float rstd = 1.0f / sqrtf(wave_sum(s) * (1.f / D) + EPS);
    v2u* o8 = (v2u*)orow + lane;
#pragma unroll
    for (int j = 0; j < 4; ++j) { v2u w; w.x = pk2(v[j].x * rstd, v[j].y * rstd); w.y = pk2(v[j].z * rstd, v[j].w * rstd); o8[64 * j] = w; }
}

__device__ __forceinline__ void p0_prologue(Frame& F) {
    LAS float* scr = (LAS float*)(F.lds + F.wave * 16384);
    const int gw = F.bx * NWAVES + F.wave, NGW = F.G * NWAVES;
    constexpr int I_IN = (D / 64) * (INW / 32), I_O = (D / 64) * (D / 32), I_UP = (D / 64) * (UPW / 32), I_DN = (FF / 64) * (D / 32), I_PL = 4 * 2;
    constexpr int I_LAYER = I_IN + I_O + I_UP + I_DN + I_PL;
    for (int it = gw; it < DEPTH * I_LAYER; it += NGW) {
        const int l = it / I_LAYER; int r = it % I_LAYER;
        unsigned char* wl = F.ws + WS_W + (size_t)l * W_LAYER;
        if (r < I_IN) { p0_item(F.in[2] + (size_t)l * D * INW, D, INW, F.in[1] + l * D, (bf16*)(wl + W_IN), 0, scr, r, F.lane); continue; } r -= I_IN;
        if (r < I_O) { p0_item(F.in[7] + (size_t)l * D * D, D, D, nullptr, (bf16*)(wl + W_O), 0, scr, r, F.lane); continue; } r -= I_O;
        if (r < I_UP) { p0_item(F.in[10] + (size_t)l * D * UPW, D, UPW, F.in[9] + l * D, (bf16*)(wl + W_UP), 1, scr, r, F.lane); continue; } r -= I_UP;
        if (r < I_DN) { p0_item(F.in[13] + (size_t)l * FF * D, FF, D, nullptr, (bf16*)(wl + W_DN), 0, scr, r, F.lane); continue; } r -= I_DN;
        { const int g = r >> 1; p0_item(F.in[3] + (size_t)(l * 4 + g) * 4096, 64, 64, nullptr, (bf16*)(F.ws + WS_POOLT) + (size_t)(l * 4 + g) * 4096, 0, scr, r & 1, F.lane); }
    }
    bf16* XN = (bf16*)(F.ws + WS_XN);
    for (int m = gw; m < M; m += NGW) rms_row_to_bf16(F.lane, F.in[0] + (size_t)m * D, XN + (size_t)m * D);
}

__device__ __forceinline__ void post_rows(Frame& F, const bf16* Y, const float* base, const float* gain, float* out, bf16* XN) {
    const int gw = F.bx * NWAVES + F.wave, NGW = F.G * NWAVES;
    f32x4 gv[4];
#pragma unroll
    for (int j = 0; j < 4; ++j) gv[j] = ((const f32x4*)gain)[F.lane + 64 * j];
    for (int m = gw; m < M; m += NGW) {
        const v2u* yr = (const v2u*)(Y + (size_t)m * D) + F.lane;
        const f32x4* br = (const f32x4*)(base + (size_t)m * D) + F.lane;
        f32x4 yv[4], xv[4]; float s = 0.f;
#pragma unroll
        for (int j = 0; j < 4; ++j) { const v2u w = yr[64 * j]; xv[j] = br[64 * j]; yv[j] = (f32x4){bf_lo(w.x), bf_hi(w.x), bf_lo(w.y), bf_hi(w.y)};
            s += (yv[j].x * yv[j].x + yv[j].y * yv[j].y) + (yv[j].z * yv[j].z + yv[j].w * yv[j].w); }
        const float rstd = 1.0f / sqrtf(wave_sum(s) * (1.f / D) + EPS);
        float s2 = 0.f;
        f32x4* orow = (f32x4*)(out + (size_t)m * D) + F.lane;
#pragma unroll
        for (int j = 0; j < 4; ++j) { xv[j] = xv[j] + yv[j] * rstd * gv[j]; orow[64 * j] = xv[j];
            s2 += (xv[j].x * xv[j].x + xv[j].y * xv[j].y) + (xv[j].z * xv[j].z + xv[j].w * xv[j].w); }
        if (XN) {
            const float r2 = 1.0f / sqrtf(wave_sum(s2) * (1.f / D) + EPS);
            v2u* o8 = (v2u*)(XN + (size_t)m * D) + F.lane;
#pragma unroll
            for (int j = 0; j < 4; ++j) { v2u w; w.x = pk2(xv[j].x * r2, xv[j].y * r2); w.y = pk2(xv[j].z * r2, xv[j].w * r2); o8[64 * j] = w; }
        }
    }
}

__device__ __forceinline__ void ld8(const bf16* p, float (&v)[8]) {
    const v4u w = *(const v4u*)p;
    v[0] = bf_lo(w.x); v[1] = bf_hi(w.x); v[2] = bf_lo(w.y); v[3] = bf_hi(w.y); v[4] = bf_lo(w.z); v[5] = bf_hi(w.z); v[6] = bf_lo(w.w); v[7] = bf_hi(w.w);
}
constexpr int KS_STRIDE = 72, VT_STRIDE = 264, VT_OFF = 256 * KS_STRIDE * 2;
__device__ __forceinline__ void attn_unit(Frame& F, int b, int nb, int hk, const bf16* PROJ, bf16* MIX, const float* sinks) {
    LAS bf16* Ks = (LAS bf16*)F.lds; LAS bf16* Vt = (LAS bf16*)(F.lds + VT_OFF);
    const int lane = F.lane, r = lane & 31, h = lane >> 5;
#pragma unroll
    for (int i = 0; i < 4; ++i) {
        const int idx = F.tid + 512 * i, row = idx >> 3, ch = idx & 7;
        int pos = nb * 128 - 128 + row; if (pos < 0) pos += 128;
        const bf16* src = PROJ + (size_t)(b * SEQ + pos) * INW + hk * 64 + ch * 8;
        const v4u kv = *(const v4u*)(src + C_K), vv = *(const v4u*)(src + C_V);
        *(LAS v4u*)(Ks + row * KS_STRIDE + ch * 8) = kv;
        LAS bf16* vd = Vt + (ch * 8) * VT_STRIDE + row;
        vd[0 * VT_STRIDE] = (bf16)(vv.x & 0xffffu); vd[1 * VT_STRIDE] = (bf16)(vv.x >> 16);
        vd[2 * VT_STRIDE] = (bf16)(vv.y & 0xffffu); vd[3 * VT_STRIDE] = (bf16)(vv.y >> 16);
        vd[4 * VT_STRIDE] = (bf16)(vv.z & 0xffffu); vd[5 * VT_STRIDE] = (bf16)(vv.z >> 16);
        vd[6 * VT_STRIDE] = (bf16)(vv.w & 0xffffu); vd[7 * VT_STRIDE] = (bf16)(vv.w >> 16);
    }
    __syncthreads();
    const int g = F.wave >> 1, head = hk * 4 + g;
    const float sink2 = sinks[head] * LOG2E;
    for (int qq = 0; qq < 2; ++qq) {
        const int qt = 2 * (F.wave & 1) + qq, i0 = 32 * qt;
        const size_t qrow = (size_t)b * SEQ + nb * 128 + i0 + r;
        bf16x8 qf[4];
#pragma unroll
        for (int ks = 0; ks < 4; ++ks) qf[ks] = *(const bf16x8*)(PROJ + qrow * INW + C_Q + head * 64 + 16 * ks + 8 * h);
        f32x16 s[5];
#pragma unroll
        for (int kt = 0; kt < 5; ++kt) {
            f32x16 a = {};
#pragma unroll
            for (int ks = 0; ks < 4; ++ks) { const bf16x8 kf = *(const LAS bf16x8*)(Ks + (32 * (qt + kt) + r) * KS_STRIDE + 16 * ks + 8 * h); a = MFMA32(kf, qf[ks], a); }
            s[kt] = a;
        }
        const int iq = i0 + r; float mx = -1e30f;
#pragma unroll
        for (int kt = 0; kt < 5; ++kt)
#pragma unroll
            for (int i = 0; i < 16; ++i) { const int j = 32 * (qt + kt) + crow(i, h);
                const bool valid = (j > iq) && (j <= iq + 128) && (nb > 0 || j >= 128);
                const float v = valid ? s[kt][i] * (0.125f * LOG2E) : -1e30f; s[kt][i] = v; mx = fmaxf(mx, v); }
        mx = fmaxf(mx, __shfl_xor(mx, 32)); mx = fmaxf(mx, sink2);
        float sum = 0.f;
#pragma unroll
        for (int kt = 0; kt < 5; ++kt)
#pragma unroll
            for (int i = 0; i < 16; ++i) { const float p = __builtin_amdgcn_exp2f(s[kt][i] - mx); s[kt][i] = p; sum += p; }
        sum += __shfl_xor(sum, 32); sum += __builtin_amdgcn_exp2f(sink2 - mx);
        const float inv = 1.0f / sum;
        f32x16 o[2] = {{}, {}};
#pragma unroll
        for (int kt = 0; kt < 5; ++kt)
#pragma unroll
            for (int st = 0; st < 2; ++st) {
                v4u pw; pw.x = pk2(s[kt][8 * st + 0], s[kt][8 * st + 1]); pw.y = pk2(s[kt][8 * st + 2], s[kt][8 * st + 3]);
                pw.z = pk2(s[kt][8 * st + 4], s[kt][8 * st + 5]); pw.w = pk2(s[kt][8 * st + 6], s[kt][8 * st + 7]);
                const bf16x8 pb = __builtin_bit_cast(bf16x8, pw);
#pragma unroll
                for (int db = 0; db < 2; ++db) {
                    const LAS bf16* vp = Vt + (32 * db + r) * VT_STRIDE + 32 * (qt + kt) + 16 * st + 4 * h;
                    const s16x4 lo = *(const LAS s16x4*)vp, hi = *(const LAS s16x4*)(vp + 8);
                    const bf16x8 va = __builtin_shufflevector(lo, hi, 0, 1, 2, 3, 4, 5, 6, 7);
                    o[db] = MFMA32(va, pb, o[db]);
                }
            }
        bf16* orow = MIX + qrow * D + 512 + head * 64;
#pragma unroll
        for (int db = 0; db < 2; ++db)
#pragma unroll
            for (int g4 = 0; g4 < 4; ++g4) { v2u w; w.x = pk2(o[db][4 * g4] * inv, o[db][4 * g4 + 1] * inv); w.y = pk2(o[db][4 * g4 + 2] * inv, o[db][4 * g4 + 3] * inv);
                *(v2u*)(orow + 32 * db + 8 * g4 + 4 * h) = w; }
    }
    __syncthreads();
}

constexpr int DL_STRIDE = 264;
__device__ __forceinline__ void pc_unit(Frame& F, int tok0, int l, const bf16* PROJ, bf16* MIX) {
    LAS bf16* Dl = (LAS bf16*)F.lds;
    const int s0 = tok0 % SEQ;
    const float* cw = F.in[5] + (size_t)l * 3 * 256;
#pragma unroll 1
    for (int i = 0; i < 4; ++i) {
        const int idx = F.tid + 512 * i, tk = idx >> 5, ch = idx & 31, grp = ch >> 3, w = 2 << grp;
        const int s = s0 + tk; const size_t row = (size_t)tok0 + tk;
        float u[8], acc[8]; ld8(PROJ + row * INW + ch * 8, u);
#pragma unroll
        for (int e = 0; e < 8; ++e) acc[e] = u[e];
        const int n = (s + 1 < w) ? s + 1 : w;
        for (int k = 1; k < n; ++k) { float t[8]; ld8(PROJ + (row - k) * INW + ch * 8, t);
#pragma unroll
            for (int e = 0; e < 8; ++e) acc[e] += t[e]; }
        const float rn = 1.0f / (float)n;
        v4u dw; dw.x = pk2(acc[0] * rn - u[0], acc[1] * rn - u[1]); dw.y = pk2(acc[2] * rn - u[2], acc[3] * rn - u[3]);
        dw.z = pk2(acc[4] * rn - u[4], acc[5] * rn - u[5]); dw.w = pk2(acc[6] * rn - u[6], acc[7] * rn - u[7]);
        *(LAS v4u*)(Dl + tk * DL_STRIDE + ch * 8) = dw;
        float y[8];
#pragma unroll
        for (int e = 0; e < 8; ++e) y[e] = 0.f;
#pragma unroll
        for (int j = 0; j < 3; ++j) {
            if (s - 2 + j >= 0) { float gc[8], uc[8]; const bf16* p = PROJ + (row - 2 + j) * INW + ch * 8; ld8(p + C_GC, gc); ld8(p + C_UC, uc);
                const f32x4 wa = *(const f32x4*)(cw + j * 256 + ch * 8), wb = *(const f32x4*)(cw + j * 256 + ch * 8 + 4);
#pragma unroll
                for (int e = 0; e < 4; ++e) { y[e] += wa[e] * gc[e] * uc[e]; y[4 + e] += wb[e] * gc[4 + e] * uc[4 + e]; } }
        }
        float gb[8]; ld8(PROJ + row * INW + C_GB + ch * 8, gb);
        v4u ow; ow.x = pk2(gb[0] * y[0], gb[1] * y[1]); ow.y = pk2(gb[2] * y[2], gb[3] * y[3]); ow.z = pk2(gb[4] * y[4], gb[5] * y[5]); ow.w = pk2(gb[6] * y[6], gb[7] * y[7]);
        *(v4u*)(MIX + row * D + 256 + ch * 8) = ow;
    }
    __syncthreads();
    {
        const int lane = F.lane, r = lane & 31, h = lane >> 5, tt = F.wave & 1, grp = F.wave >> 1;
        const bf16* PT = (const bf16*)(F.ws + WS_POOLT) + (size_t)(l * 4 + grp) * 4096;
        const float* psc = F.in[4] + (size_t)l * 256 + grp * 64;
        bf16x8 df[4];
#pragma unroll
        for (int ks = 0; ks < 4; ++ks) df[ks] = *(const LAS bf16x8*)(Dl + (32 * tt + r) * DL_STRIDE + 64 * grp + 16 * ks + 8 * h);
#pragma unroll
        for (int db = 0; db < 2; ++db) {
            f32x16 a = {};
#pragma unroll
            for (int ks = 0; ks < 4; ++ks) { const bf16x8 wf = *(const bf16x8*)(PT + (32 * db + r) * 64 + 16 * ks + 8 * h); a = MFMA32(wf, df[ks], a); }
            bf16* orow = MIX + ((size_t)tok0 + 32 * tt + r) * D + grp * 64 + 32 * db;
#pragma unroll
            for (int g4 = 0; g4 < 4; ++g4) { const f32x4 sc = *(const f32x4*)(psc + 32 * db + 8 * g4 + 4 * h);
                v2u w; w.x = pk2(a[4 * g4] * sc[0], a[4 * g4 + 1] * sc[1]); w.y = pk2(a[4 * g4 + 2] * sc[2], a[4 * g4 + 3] * sc[3]);
                *(v2u*)(orow + 8 * g4 + 4 * h) = w; }
        }
    }
    __syncthreads();
}

__device__ __forceinline__ void mixer_phase(Frame& F, int l) {
    const bf16* PROJ = (const bf16*)(F.ws + WS_PROJ); bf16* MIX = (bf16*)(F.ws + WS_MIX);
    const float* sinks = F.in[6] + l * 8;
    for (int u = F.bx; u < BATCH * 32 * 2; u += F.G) { const int hk = u & 1, nb = (u >> 1) & 31, b = u >> 6; attn_unit(F, b, nb, hk, PROJ, MIX, sinks); }
    for (int u = F.bx; u < M / 64; u += F.G) pc_unit(F, u * 64, l, PROJ, MIX);
}

__device__ __forceinline__ void fixup_phase(Frame& F, int l) {
    const float* head = (const float*)(F.ws + WS_HEAD); const float* tail = (const float*)(F.ws + WS_TAIL);
    const float* cw = F.in[11] + (size_t)l * 3 * UPW; const float* cb = F.in[12] + (size_t)l * UPW;
    bf16* H = (bf16*)(F.ws + WS_H);
    const int nth = F.G * NWAVES * 64;
    for (int idx = F.bx * (NWAVES * 64) + F.tid; idx < 128 * 2 * (FF / 4); idx += nth) {
        const int pm = idx / (2 * (FF / 4)), rem = idx % (2 * (FF / 4)), r = rem / (FF / 4), f = 4 * (rem % (FF / 4));
        if ((pm & 15) == 0) continue;
        f32x4 y[2];
#pragma unroll
        for (int hf = 0; hf < 2; ++hf) { const int c = hf * FF + f;
            const f32x4 cur = *(const f32x4*)(head + ((size_t)pm * 2 + r) * UPW + c);
            const f32x4 t0 = *(const f32x4*)(tail + ((size_t)(pm - 1) * 2 + 0) * UPW + c), t1 = *(const f32x4*)(tail + ((size_t)(pm - 1) * 2 + 1) * UPW + c);
            const f32x4 h0 = *(const f32x4*)(head + ((size_t)pm * 2 + 0) * UPW + c);
            const f32x4 p1 = r == 0 ? t1 : h0, p2 = r == 0 ? t0 : t1;
            const f32x4 w0 = *(const f32x4*)(cw + c), w1 = *(const f32x4*)(cw + UPW + c), w2 = *(const f32x4*)(cw + 2 * UPW + c), bb = *(const f32x4*)(cb + c);
            y[hf] = w2 * cur + w1 * p1 + w0 * p2 + bb; }
        float hv[4];
#pragma unroll
        for (int j = 0; j < 4; ++j) { const float g = y[0][j]; hv[j] = g * __builtin_amdgcn_rcpf(1.0f + __builtin_amdgcn_exp2f(-LOG2E * g)) * y[1][j]; }
        v2u w; w.x = pk2(hv[0], hv[1]); w.y = pk2(hv[2], hv[3]);
        *(v2u*)(H + ((size_t)pm * 256 + r) * FF + f) = w;
    }
}

#ifndef MK_MULTI
#define MK_MULTI 0
#endif
constexpr int N_PHASES = 1 + 8 * DEPTH;
struct Args { const float* in[15]; float* out; unsigned char* ws; int ph_lo, ph_hi; };
__global__ void __launch_bounds__(NWAVES * 64, 2) mk_fwd(Args args) {
    extern __shared__ __attribute__((aligned(16))) unsigned char lds[];
    cg::grid_group grid = cg::this_grid();
    for (int ph = args.ph_lo; ph < args.ph_hi; ++ph) {
        Frame F;
        { int t = threadIdx.x; asm volatile("" : "+v"(t)); F.tid = t; }
        { unsigned char* w = args.ws; asm volatile("" : "+s"(w)); F.ws = w; }
        F.lds = (LAS unsigned char*)lds;
        F.lane = F.tid & 63; F.wave = __builtin_amdgcn_readfirstlane(F.tid >> 6);
        F.G = gridDim.x; F.bx = blockIdx.x;
#pragma unroll
        for (int i = 0; i < 15; ++i) F.in[i] = args.in[i];
        F.out = args.out;
        bf16* XN = (bf16*)(F.ws + WS_XN); bf16* PROJ = (bf16*)(F.ws + WS_PROJ); bf16* MIX = (bf16*)(F.ws + WS_MIX); bf16* HB = (bf16*)(F.ws + WS_H); bf16* Y = (bf16*)(F.ws + WS_Y);
        if (ph == 0) { p0_prologue(F); }
        else {
            const int l = (ph - 1) >> 3, k = (ph - 1) & 7;
            unsigned char* wl = F.ws + WS_W + (size_t)l * W_LAYER;
            if (k == 0 || k == 2 || k == 6) {
                pg8::Gemm g; pg8::EpiBf16 E;
                if (k == 0) { g = pg8::Gemm{XN, (const bf16*)(wl + W_IN), M, INW, D}; E = pg8::EpiBf16{PROJ, INW}; }
                else if (k == 2) { g = pg8::Gemm{MIX, (const bf16*)(wl + W_O), M, D, D}; E = pg8::EpiBf16{Y, D}; }
                else { g = pg8::Gemm{HB, (const bf16*)(wl + W_DN), M, D, FF}; E = pg8::EpiBf16{Y, D}; }
                pg8::StaticOrder S; S.init(M, g.N, F.G, F.bx);
                pg8::gemm_phase<pg8::EpiBf16, pg8::StaticOrder, true, true>(F.lds, g, S, E, F.tid);
            } else if (k == 1) {
                mixer_phase(F, l);
            } else if (k == 3 || k == 7) {
                const float* base = (l == 0 && k == 3) ? F.in[0] : F.out;
                const float* gain = (k == 3 ? F.in[8] : F.in[14]) + (size_t)l * D;
                post_rows(F, Y, base, gain, F.out, (k == 7 && l == DEPTH - 1) ? (bf16*)nullptr : XN);
            } else if (k == 4) {
                pg8::Gemm g{XN, (const bf16*)(wl + W_UP), M, UPW, D};
                pg8::EpiUpConv E{HB, F.in[11] + (size_t)l * 3 * UPW, F.in[12] + (size_t)l * UPW, (float*)(F.ws + WS_HEAD), (float*)(F.ws + WS_TAIL), (PG8_LAS float*)(F.lds + BND_OFF)};
                pg8::StaticOrder S; S.init(M, UPW, F.G, F.bx);
                pg8::gemm_phase<pg8::EpiUpConv, pg8::StaticOrder, true, true>(F.lds, g, S, E, F.tid);
            } else {
                fixup_phase(F, l);
            }
        }
        if (ph + 1 < args.ph_hi) grid.sync();
    }
}

extern "C" void kernel_launch(void* const* d_in, const int* in_sizes, int n_in, void* d_out, int out_size, void* d_ws, size_t ws_size, hipStream_t stream) {
    static int grid = 0;
    if (grid == 0) {
        if (n_in != 15 || out_size != M * D || ws_size < WS_END) { fprintf(stderr, "kernel_launch: unexpected problem (n_in %d, out %d, ws %zu); nothing launched\n", n_in, out_size, ws_size); grid = -1; return; }
        int dev = 0, cus = 0, per_cu = 0;
        if (hipGetDevice(&dev) != hipSuccess || hipDeviceGetAttribute(&cus, hipDeviceAttributeMultiprocessorCount, dev) != hipSuccess) { grid = -1; return; }
        if (hipFuncSetAttribute((const void*)mk_fwd, hipFuncAttributeMaxDynamicSharedMemorySize, LDS_BYTES) != hipSuccess) { fprintf(stderr, "kernel_launch: hipFuncSetAttribute failed\n"); grid = -1; return; }
        if (hipOccupancyMaxActiveBlocksPerMultiprocessor(&per_cu, (const void*)mk_fwd, NWAVES * 64, LDS_BYTES) != hipSuccess || per_cu < 1) { fprintf(stderr, "kernel_launch: occupancy query says %d\n", per_cu); per_cu = 1; }
        (void)hipGetLastError();
        grid = cus * per_cu;
    }
    if (grid < 0) return;
    Args a{};
    for (int i = 0; i < 15; ++i) a.in[i] = (const float*)d_in[i];
    a.out = (float*)d_out; a.ws = (unsigned char*)d_ws;
#if MK_MULTI
    for (int ph = 0; ph < N_PHASES; ++ph) { a.ph_lo = ph; a.ph_hi = ph + 1; hipLaunchKernelGGL(mk_fwd, dim3(grid), dim3(NWAVES * 64), LDS_BYTES, stream, a); }
#else
    a.ph_lo = 0; a.ph_hi = N_PHASES;
    void* kargs[] = {&a};
    hipError_t e = hipLaunchCooperativeKernel((const void*)mk_fwd, dim3(grid), dim3(NWAVES * 64), kargs, LDS_BYTES, stream);
    if (e != hipSuccess) fprintf(stderr, "kernel_launch: cooperative launch failed: %s (grid %d)\n", hipGetErrorString(e), grid);
#endif
}
```

```cpp
#include <hip/hip_runtime.h>
#include <hip/hip_cooperative_groups.h>
#include <cstdio>
#include <cstdint>
namespace cg = cooperative_groups;
namespace pg8 {
#define PG8_LAS __attribute__((address_space(3)))
typedef unsigned short bf16_t;
typedef short bf16x8 __attribute__((ext_vector_type(8)));
typedef float f32x4 __attribute__((ext_vector_type(4)));
typedef unsigned u32x4 __attribute__((ext_vector_type(4)));
constexpr int BM = 256, BK = 64, HALF = 128, HTB = HALF * BK * 2  , STAGE_BYTES = 8 * HTB, NXCD = 8, WGM = 8;

__host__ __device__ __forceinline__ int lds_byte(int r, int c) { const int st = (r >> 4) * 2 + (c >> 5), rr = r & 15, cc = c & 31, ob = rr * 64 + cc * 2; return st * 1024 + (ob ^ (((ob >> 9) & 1) << 5)); }
__host__ __device__ __forceinline__ void stage_rc(int b, int& R, int& C) { const int st = b / 1024, sb = b % 1024, swz = sb ^ (((sb >> 9) & 1) << 5); R = (st >> 1) * 16 + swz / 64; C = (st & 1) * 32 + (swz % 64) / 2; }
__host__ __device__ __forceinline__ int perm32(int rho) { const int n = rho >> 4, i = rho & 15; return 8 * (i >> 2) + 4 * n + (i & 3); }

struct Unit { int pm, pn; };
struct Gemm { const bf16_t* A; const bf16_t* Bt; int M, N, K; };

struct StaticOrder {
    int nM, nN, nwg, G, c;
    __host__ __device__ void init(int M, int N, int G_, int c_) { nM = M / BM; nN = N / BM; nwg = nM * nN; G = G_; c = c_; }
    __host__ __device__ bool next(int i, Unit& u) const {
        const long L = (long)i * G + c; if (L >= nwg) return false;
        int wgid = (int)L; { const int q = nwg / NXCD, r = nwg % NXCD, xcd = wgid % NXCD, off = wgid / NXCD; wgid = (xcd < r ? xcd * (q + 1) : r * (q + 1) + (xcd - r) * q) + off; }
        const int nig = WGM * nN, gid = wgid / nig, fm = gid * WGM, gsz = (nM - fm) < WGM ? (nM - fm) : WGM;
        u.pm = fm + ((wgid % nig) % gsz); u.pn = (wgid % nig) / gsz; return true;
    }
    __device__ __forceinline__ void a_ready(const Unit&) const {}
    __device__ __forceinline__ void done(const Unit&) const {}
};

__device__ __forceinline__ unsigned cvt_pk_bf16(float lo, float hi) { unsigned r; asm volatile("v_cvt_pk_bf16_f32 %0, %1, %2" : "=v"(r) : "v"(lo), "v"(hi)); return r; }
typedef float f32x2 __attribute__((ext_vector_type(2)));
typedef unsigned u32x2 __attribute__((ext_vector_type(2)));
struct EpiBf16 {
    static constexpr bool PERM = true, AFTER_DRAIN = false;
    bf16_t* O; int ldc; const float* rs;
    __device__ __forceinline__ void operator()(f32x4 (&acc)[2][2][4][2], const Unit& u, int wr, int wc, int fr, int fq) const {
        const int row0 = u.pm * BM + wr * 64 + fr; const int col0 = u.pn * BM + wc * 32 + 8 * fq;
#pragma unroll
        for (int ai = 0; ai < 2; ++ai)
#pragma unroll
            for (int m = 0; m < 4; ++m) { bf16_t* rowp = O + (size_t)(row0 + ai * HALF + m * 16) * ldc + col0;
                const float sc = rs ? rs[row0 + ai * HALF + m * 16] : 1.0f;
#pragma unroll
                for (int bj = 0; bj < 2; ++bj) { const f32x4 v0 = acc[ai][bj][m][0] * sc, v1 = acc[ai][bj][m][1] * sc;
                    u32x4 w; w.x = cvt_pk_bf16(v0[0], v0[1]); w.y = cvt_pk_bf16(v0[2], v0[3]); w.z = cvt_pk_bf16(v1[0], v1[1]); w.w = cvt_pk_bf16(v1[2], v1[3]);
                    *(u32x4*)(rowp + bj * HALF) = w; } }
    }
};

#ifndef ROT_DPP
#define ROT_DPP 0
#endif
__device__ __forceinline__ float rot_lane1(float v) { return __builtin_bit_cast(float, __builtin_amdgcn_update_dpp(0, __builtin_bit_cast(int, v), 0x121, 0xf, 0xf, false)); }
__device__ __forceinline__ float rot_lane2(float v) { return __builtin_bit_cast(float, __builtin_amdgcn_update_dpp(0, __builtin_bit_cast(int, v), 0x122, 0xf, 0xf, false)); }
struct EpiUpConv {
    static constexpr bool PERM = true, AFTER_DRAIN = false;
    static constexpr int FF = 2816, UPW = 5632;
    bf16_t* H; const float* cw; const float* cb; float* head; float* tail; PG8_LAS float* bnd; const float* rs;
    __device__ __forceinline__ void operator()(f32x4 (&acc)[2][2][4][2], const Unit& u, int wr, int wc, int fr, int fq) const {
#pragma unroll
        for (int ai = 0; ai < 2; ++ai)
#pragma unroll
            for (int m = 0; m < 4; ++m) { const float sc = rs[u.pm * BM + ai * HALF + wr * 64 + m * 16 + fr];
#pragma unroll
                for (int bj = 0; bj < 2; ++bj)
#pragma unroll
                    for (int n = 0; n < 2; ++n) acc[ai][bj][m][n] *= sc; }
        const int xcol = wc * 32 + 8 * fq;
        const int fcol = u.pn * 128 + xcol;
        if (fr >= 14) {
#pragma unroll
            for (int ai = 0; ai < 2; ++ai)
#pragma unroll
                for (int bj = 0; bj < 2; ++bj)
#pragma unroll
                    for (int n = 0; n < 2; ++n) *(PG8_LAS f32x4*)(bnd + ((2 * ai + wr) * 2 + (fr - 14)) * 256 + bj * 128 + xcol + 4 * n) = acc[ai][bj][3][n];
        }
        if (wr == 0 && fr < 2) {
#pragma unroll
            for (int bj = 0; bj < 2; ++bj)
#pragma unroll
                for (int n = 0; n < 2; ++n) *(f32x4*)(head + ((size_t)u.pm * 2 + fr) * UPW + bj * FF + fcol + 4 * n) = acc[0][bj][0][n];
        }
        if (wr == 1 && fr >= 14) {
#pragma unroll
            for (int bj = 0; bj < 2; ++bj)
#pragma unroll
                for (int n = 0; n < 2; ++n) *(f32x4*)(tail + ((size_t)u.pm * 2 + (fr - 14)) * UPW + bj * FF + fcol + 4 * n) = acc[1][bj][3][n];
        }
        asm volatile("s_waitcnt lgkmcnt(0)" ::: "memory"); __builtin_amdgcn_s_barrier(); asm volatile("" ::: "memory");
        u32x2 pk0[2][4];
#pragma unroll
        for (int n = 0; n < 2; ++n) {
            f32x4 w0[2], w1[2], w2[2], bb[2];
#pragma unroll
            for (int bj = 0; bj < 2; ++bj) { const int c = bj * FF + fcol + 4 * n;
                w0[bj] = *(const f32x4*)(cw + c); w1[bj] = *(const f32x4*)(cw + UPW + c); w2[bj] = *(const f32x4*)(cw + 2 * UPW + c); bb[bj] = *(const f32x4*)(cb + c); }
#pragma unroll
            for (int ai = 0; ai < 2; ++ai) {
                const int blk = 2 * ai + wr;
                f32x4 y[2][4];
#pragma unroll
                for (int bj = 0; bj < 2; ++bj) {
                    f32x4 pr1 = (f32x4){0.f, 0.f, 0.f, 0.f}, pr2 = (f32x4){0.f, 0.f, 0.f, 0.f};
                    if (blk > 0) {
                        pr1 = *(const PG8_LAS f32x4*)(bnd + ((blk - 1) * 2 + 1) * 256 + bj * 128 + xcol + 4 * n);
                        pr2 = *(const PG8_LAS f32x4*)(bnd + ((blk - 1) * 2 + (fr == 0 ? 0 : 1)) * 256 + bj * 128 + xcol + 4 * n);
                    }
#pragma unroll
                    for (int m = 0; m < 4; ++m) {
                        const f32x4 cur = acc[ai][bj][m][n]; f32x4 r1, r2;
#pragma unroll
                        for (int j = 0; j < 4; ++j) { r1[j] = rot_lane1(cur[j]); r2[j] = rot_lane2(cur[j]); }
                        const f32x4 p1 = fr >= 1 ? r1 : pr1, p2 = fr >= 2 ? r2 : pr2;
                        y[bj][m] = w2[bj] * cur + w1[bj] * p1 + w0[bj] * p2 + bb[bj];
                        pr1 = r1; pr2 = r2;
                    }
                }
#pragma unroll
                for (int m = 0; m < 4; ++m) {
                    f32x4 hv;
#pragma unroll
                    for (int j = 0; j < 4; ++j) { const float g = y[0][m][j]; hv[j] = g * __builtin_amdgcn_rcpf(1.0f + __builtin_amdgcn_exp2f(-1.4426950408889634f * g)) * y[1][m][j]; }
                    if (n == 0) { pk0[ai][m].x = cvt_pk_bf16(hv[0], hv[1]); pk0[ai][m].y = cvt_pk_bf16(hv[2], hv[3]); }
                    else { u32x4 w; w.x = pk0[ai][m].x; w.y = pk0[ai][m].y; w.z = cvt_pk_bf16(hv[0], hv[1]); w.w = cvt_pk_bf16(hv[2], hv[3]);
                        const int row = u.pm * BM + ai * HALF + wr * 64 + m * 16 + fr;
                        *(u32x4*)(H + (size_t)row * FF + fcol) = w; }
                }
            }
        }
    }
};

template <class Epi, class Sched, bool ALIGN_EPI = false, bool SP2 = false>
__device__ __forceinline__ void gemm_phase(PG8_LAS unsigned char* lds, const Gemm g, const Sched& S, const Epi& E, const int tid) {
    const int wid = __builtin_amdgcn_readfirstlane(tid >> 6), lane = tid & 63, wr = wid >> 2, wc = wid & 3, fr = lane & 15, fq = lane >> 4;
    const int K = g.K, nt = K / BK;
    unsigned voffA[2], voffB[2];
#pragma unroll
    for (int i = 0; i < 2; ++i) { int R, C; stage_rc(tid * 16 + i * 8192, R, C); const int Rb = Epi::PERM ? ((R & ~31) + perm32(R & 31)) : R;
        voffA[i] = (unsigned)(R * K + C) * 2u; voffB[i] = (unsigned)(Rb * K + C) * 2u; }
    const size_t kstep = (size_t)(BK * 2);
    const size_t hstep = (size_t)HALF * K * 2;
    const size_t tstep = 2 * hstep;
    const unsigned ldsw = (unsigned)wid * 1024u;
    const int aoff = lds_byte(wr * 64 + fr, fq * 8), boff = lds_byte(wc * 32 + fr, fq * 8);
#define PG8_SA(b, h) (((b) * 2 + (h)) * HTB)
#define PG8_SB(b, h) ((4 + (b) * 2 + (h)) * HTB)
#define PG8_STAGE(bufoff, gbase, voff) do { _Pragma("unroll") for (int _i = 0; _i < 2; ++_i) \
        __builtin_amdgcn_global_load_lds((const unsigned*)((const char*)(gbase) + (voff)[_i]), (PG8_LAS unsigned*)(lds + (bufoff) + ldsw + _i * 8192), 16, 0, 0); } while (0)
#define PG8_LDA(dst, b, h) do { _Pragma("unroll") for (int m = 0; m < 4; ++m) _Pragma("unroll") for (int k = 0; k < 2; ++k) dst[m][k] = *(const PG8_LAS bf16x8*)(lds + PG8_SA(b, h) + aoff + m * 2048 + k * 1024); } while (0)
#define PG8_LDB(dst, b, h) do { _Pragma("unroll") for (int n = 0; n < 2; ++n) _Pragma("unroll") for (int k = 0; k < 2; ++k) dst[n][k] = *(const PG8_LAS bf16x8*)(lds + PG8_SB(b, h) + boff + n * 2048 + k * 1024); } while (0)
#define PG8_MMA(ai, bj, At, Bt) do { __builtin_amdgcn_s_setprio(1); _Pragma("unroll") for (int m = 0; m < 4; ++m) _Pragma("unroll") for (int n = 0; n < 2; ++n) _Pragma("unroll") for (int k = 0; k < 2; ++k) \
        acc[ai][bj][m][n] = __builtin_amdgcn_mfma_f32_16x16x32_bf16(Bt[n][k], At[m][k], acc[ai][bj][m][n], 0, 0, 0); __builtin_amdgcn_s_setprio(0); } while (0)
#define PG8_WAIT_V(n) asm volatile("s_waitcnt vmcnt(" #n ")" ::: "memory")
#define PG8_WAIT_L(n) asm volatile("s_waitcnt lgkmcnt(" #n ")" ::: "memory")
#define PG8_BAR __builtin_amdgcn_s_barrier()
#define PG8_SCHED __builtin_amdgcn_sched_barrier(0)
    Unit cur, nxt; int ui = 0;
    if (!S.next(0, cur)) return;
    f32x4 acc[2][2][4][2];
#pragma unroll
    for (int a = 0; a < 2; ++a)
#pragma unroll
        for (int b = 0; b < 2; ++b)
#pragma unroll
            for (int m = 0; m < 4; ++m)
#pragma unroll
                for (int n = 0; n < 2; ++n) acc[a][b][m][n] = (f32x4){0.f, 0.f, 0.f, 0.f};
    bf16x8 At[4][2], B0[2][2], B1[2][2];
    const char* cA = (const char*)g.A + (size_t)cur.pm * tstep; const char* cB = (const char*)g.Bt + (size_t)cur.pn * tstep;
    S.a_ready(cur);
    if constexpr (SP2) {
        PG8_STAGE(PG8_SB(0, 0), cB, voffB); PG8_STAGE(PG8_SB(0, 1), cB + hstep, voffB); PG8_STAGE(PG8_SA(0, 0), cA, voffA); PG8_STAGE(PG8_SA(0, 1), cA + hstep, voffA);
        if (wr == 1) PG8_BAR;
        PG8_WAIT_V(2); PG8_BAR;
        PG8_STAGE(PG8_SB(1, 0), cB + kstep, voffB); PG8_STAGE(PG8_SA(1, 0), cA + kstep, voffA); PG8_STAGE(PG8_SB(1, 1), cB + hstep + kstep, voffB);
        PG8_WAIT_V(6); PG8_BAR;
    } else {
        PG8_STAGE(PG8_SB(0, 0), cB, voffB); PG8_STAGE(PG8_SA(0, 0), cA, voffA); PG8_STAGE(PG8_SB(0, 1), cB + hstep, voffB); PG8_STAGE(PG8_SA(0, 1), cA + hstep, voffA);
        if (wr == 1) PG8_BAR;
        PG8_WAIT_V(4); PG8_BAR;
        PG8_STAGE(PG8_SB(1, 0), cB + kstep, voffB); PG8_STAGE(PG8_SA(1, 0), cA + kstep, voffA); PG8_STAGE(PG8_SB(1, 1), cB + hstep + kstep, voffB);
        PG8_WAIT_V(6); PG8_BAR;
    }
    for (;;) {
        const bool has_next = S.next(ui + 1, nxt);
        const char* nA = has_next ? (const char*)g.A + (size_t)nxt.pm * tstep : cA; const char* nB = has_next ? (const char*)g.Bt + (size_t)nxt.pn * tstep : cB;
        for (int t = 0; t < nt; t += 2) {
            const bool last = (t == nt - 2);
            const char* a1 = cA + (size_t)(t + 1) * kstep;
            const char* a2 = last ? nA : cA + (size_t)(t + 2) * kstep; const char* b2 = last ? nB : cB + (size_t)(t + 2) * kstep;
            const char* a3 = a2 + kstep; const char* b3 = b2 + kstep;
            if (last && has_next) S.a_ready(nxt);
            if constexpr (SP2) {
            PG8_LDB(B0, 0, 0); PG8_LDB(B1, 0, 1); PG8_SCHED; PG8_LDA(At, 0, 0); PG8_STAGE(PG8_SA(1, 1), a1 + hstep, voffA);
            PG8_WAIT_V(8); PG8_WAIT_L(0); PG8_BAR; PG8_MMA(0, 0, At, B0); PG8_MMA(0, 1, At, B1); PG8_BAR; PG8_SCHED;
            PG8_LDA(At, 0, 1); PG8_STAGE(PG8_SB(0, 0), b2, voffB); PG8_STAGE(PG8_SB(0, 1), b2 + hstep, voffB); PG8_STAGE(PG8_SA(0, 0), a2, voffA);
            PG8_WAIT_V(8); PG8_WAIT_L(0); PG8_BAR; PG8_MMA(1, 0, At, B0); PG8_MMA(1, 1, At, B1); PG8_BAR; PG8_SCHED;
            PG8_LDB(B0, 1, 0); PG8_LDB(B1, 1, 1); PG8_SCHED; PG8_LDA(At, 1, 0); PG8_STAGE(PG8_SA(0, 1), a2 + hstep, voffA);
            PG8_WAIT_V(8); PG8_WAIT_L(0); PG8_BAR; PG8_MMA(0, 0, At, B0); PG8_MMA(0, 1, At, B1); PG8_BAR; PG8_SCHED;
            PG8_LDA(At, 1, 1); PG8_STAGE(PG8_SB(1, 0), b3, voffB); PG8_STAGE(PG8_SB(1, 1), b3 + hstep, voffB); PG8_STAGE(PG8_SA(1, 0), a3, voffA);
            PG8_WAIT_V(8); PG8_WAIT_L(0); PG8_BAR; PG8_MMA(1, 0, At, B0); PG8_MMA(1, 1, At, B1); PG8_BAR; PG8_SCHED;
            } else {
            PG8_LDB(B0, 0, 0); PG8_SCHED; PG8_LDA(At, 0, 0); PG8_STAGE(PG8_SA(1, 1), a1 + hstep, voffA);
            PG8_WAIT_L(8); PG8_BAR; PG8_WAIT_L(0); PG8_MMA(0, 0, At, B0); PG8_BAR; PG8_SCHED;
            PG8_LDB(B1, 0, 1); PG8_STAGE(PG8_SB(0, 0), b2, voffB);
            PG8_BAR; PG8_WAIT_L(0); PG8_MMA(0, 1, At, B1); PG8_BAR;
            PG8_LDA(At, 0, 1); PG8_STAGE(PG8_SA(0, 0), a2, voffA);
            PG8_BAR; PG8_WAIT_L(0); PG8_MMA(1, 0, At, B0); PG8_BAR; PG8_SCHED;
            PG8_STAGE(PG8_SB(0, 1), b2 + hstep, voffB);
            PG8_WAIT_V(6); PG8_BAR; PG8_MMA(1, 1, At, B1); PG8_BAR;
            PG8_LDB(B0, 1, 0); PG8_SCHED; PG8_LDA(At, 1, 0); PG8_STAGE(PG8_SA(0, 1), a2 + hstep, voffA);
            PG8_WAIT_L(8); PG8_BAR; PG8_WAIT_L(0); PG8_MMA(0, 0, At, B0); PG8_BAR; PG8_SCHED;
            PG8_LDB(B1, 1, 1); PG8_STAGE(PG8_SB(1, 0), b3, voffB);
            PG8_BAR; PG8_WAIT_L(0); PG8_MMA(0, 1, At, B1); PG8_BAR;
            PG8_LDA(At, 1, 1); PG8_STAGE(PG8_SA(1, 0), a3, voffA);
            PG8_BAR; PG8_WAIT_L(0); PG8_MMA(1, 0, At, B0); PG8_BAR; PG8_SCHED;
            PG8_STAGE(PG8_SB(1, 1), b3 + hstep, voffB);
            PG8_WAIT_V(6); PG8_BAR; PG8_MMA(1, 1, At, B1); PG8_BAR;
            }
        }
        if constexpr (ALIGN_EPI) { if (wr == 0) PG8_BAR; }
        if constexpr (!Epi::AFTER_DRAIN) { E(acc, cur, wr, wc, fr, fq); S.done(cur); }
        if (!has_next) break;
#pragma unroll
        for (int a = 0; a < 2; ++a)
#pragma unroll
            for (int b = 0; b < 2; ++b)
#pragma unroll
                for (int m = 0; m < 4; ++m)
#pragma unroll
                    for (int n = 0; n < 2; ++n) acc[a][b][m][n] = (f32x4){0.f, 0.f, 0.f, 0.f};
        cur = nxt; cA = nA; cB = nB; ++ui;
        if constexpr (ALIGN_EPI) { if (wr == 1) PG8_BAR; }
    }
    PG8_WAIT_V(0);
    if constexpr (!ALIGN_EPI) { if (wr == 0) PG8_BAR; }
    PG8_BAR;
    if constexpr (Epi::AFTER_DRAIN) { E.fused(acc, cur, wr, wc, fr, fq, lds, wid, lane); S.done(cur); }
#undef PG8_SA
#undef PG8_SB
#undef PG8_STAGE
#undef PG8_LDA
#undef PG8_LDB
#undef PG8_MMA
#undef PG8_WAIT_V
#undef PG8_WAIT_L
#undef PG8_BAR
#undef PG8_SCHED
}
}

constexpr int NWAVES = 8;
constexpr int BATCH = 8, SEQ = 4096, D = 1024, DEPTH = 4, M = BATCH * SEQ;
constexpr int INW = 1792, FF = 2816, UPW = 2 * FF;
constexpr int C_GB = 256, C_GC = 512, C_UC = 768, C_Q = 1024, C_K = 1536, C_V = 1664;
constexpr float EPS = 1e-6f;
constexpr float LOG2E = 1.4426950408889634f;

constexpr size_t MiB = 1u << 20;
constexpr size_t WS_W = 1 * MiB;
constexpr size_t W_LAYER = 22 * MiB, W_IN = 0, W_O = (size_t)INW * D * 2, W_UP = W_O + (size_t)D * D * 2, W_DN = W_UP + (size_t)UPW * D * 2;
static_assert(W_DN + (size_t)D * FF * 2 <= W_LAYER, "weight layer map");
constexpr size_t WS_POOLT = 89 * MiB;
constexpr size_t WS_XN = 90 * MiB;
constexpr size_t WS_PROJ = 154 * MiB;
constexpr size_t WS_MIX = 266 * MiB;
constexpr size_t WS_H = 154 * MiB;
constexpr size_t WS_Y = 330 * MiB;
constexpr size_t WS_HEAD = 394 * MiB, WS_TAIL = 400 * MiB;
constexpr size_t WS_RSTD = 406 * MiB;
constexpr size_t WS_END = 407 * MiB;
static_assert(WS_PROJ + (size_t)M * INW * 2 <= WS_MIX && WS_H + (size_t)M * FF * 2 <= WS_Y && WS_HEAD + (size_t)128 * 2 * UPW * 4 <= WS_TAIL, "d_ws map");

constexpr int RING_BYTES = 131072, BND_OFF = RING_BYTES, LDS_BYTES = 147456;

#define LAS __attribute__((address_space(3)))
typedef unsigned short bf16;
typedef unsigned v4u __attribute__((ext_vector_type(4)));
typedef unsigned v2u __attribute__((ext_vector_type(2)));
typedef float f32x4 __attribute__((ext_vector_type(4)));
typedef float f32x16 __attribute__((ext_vector_type(16)));
typedef short bf16x8 __attribute__((ext_vector_type(8)));
typedef short s16x4 __attribute__((ext_vector_type(4)));
#define LDS_WAIT() asm volatile("s_waitcnt lgkmcnt(0)" ::: "memory")
#define MFMA32(a, b, c) __builtin_amdgcn_mfma_f32_32x32x16_bf16((a), (b), (c), 0, 0, 0)

__device__ __forceinline__ unsigned f2bf(float f) { unsigned u = __builtin_bit_cast(unsigned, f); return (u + 0x7fffu + ((u >> 16) & 1u)) >> 16; }
__device__ __forceinline__ unsigned pk2(float lo, float hi) { return f2bf(lo) | (f2bf(hi) << 16); }
__device__ __forceinline__ float bf_lo(unsigned w) { return __builtin_bit_cast(float, w << 16); }
__device__ __forceinline__ float bf_hi(unsigned w) { return __builtin_bit_cast(float, w & 0xffff0000u); }
__device__ __forceinline__ int crow(int r, int hi) { return (r & 3) + 8 * (r >> 2) + 4 * hi; }
__device__ __forceinline__ float lane_xor(float v, int lane, int o) { return __builtin_bit_cast(float, __builtin_amdgcn_ds_bpermute((lane ^ o) << 2, __builtin_bit_cast(int, v))); }
__device__ __forceinline__ float wave_sum(float v, int lane) {
#pragma unroll
    for (int o = 1; o < 64; o <<= 1) v += lane_xor(v, lane, o);
    return v;
}

struct Frame {
    LAS unsigned char* lds;
    int tid, lane, wave, G, bx;
    const float* in[15]; float* out; unsigned char* ws;
};

__device__ __forceinline__ void p0_item(const float* W, int K, int N, const float* gain, bf16* WT, int mode, LAS float* scr, int item, int lane) {
    const int nblk = N / 32, kb = item / nblk, nb = item % nblk, k0 = 64 * kb, n0 = 32 * nb;
#pragma unroll 8
    for (int i = 0; i < 32; ++i) { const int kk = 2 * i + (lane >> 5); const float gsc = gain ? gain[k0 + kk] : 1.0f; scr[kk * 33 + (lane & 31)] = W[(size_t)(k0 + kk) * N + n0 + (lane & 31)] * gsc; }
    LDS_WAIT(); asm volatile("" ::: "memory");
    int d0 = n0;
    if (mode == 1) { d0 = (n0 < FF) ? 256 * (n0 / 128) + (n0 % 128) : 256 * ((n0 - FF) / 128) + 128 + ((n0 - FF) % 128); }
    const int c = lane & 7;
#pragma unroll
    for (int j = 0; j < 4; ++j) { const int n = (lane >> 3) + 8 * j; const LAS float* s = scr + (8 * c) * 33 + n;
        v4u o; o.x = pk2(s[0 * 33], s[1 * 33]); o.y = pk2(s[2 * 33], s[3 * 33]); o.z = pk2(s[4 * 33], s[5 * 33]); o.w = pk2(s[6 * 33], s[7 * 33]);
        *(v4u*)(WT + (size_t)(d0 + n) * K + k0 + 8 * c) = o; }
    LDS_WAIT(); asm volatile("" ::: "memory");
}

__device__ __forceinline__ void x_row_to_bf16(int lane, const float* xrow, bf16* orow, float* rstd_out) {
    const f32x4* xr = (const f32x4*)xrow + lane;
    f32x4 v[4]; float s = 0.f;
#pragma unroll
    for (int j = 0; j < 4; ++j) { v[j] = xr[64 * j]; s += (v[j].x * v[j].x + v[j].y * v[j].y) + (v[j].z * v[j].z + v[j].w * v[j].w); }
    const float rstd = 1.0f / sqrtf(wave_sum(s, lane) * (1.f / D) + EPS);
    if (lane == 0) *rstd_out = rstd;
    v2u* o8 = (v2u*)orow + lane;
#pragma unroll
    for (int j = 0; j < 4; ++j) { v2u w; w.x = pk2(v[j].x, v[j].y); w.y = pk2(v[j].z, v[j].w); o8[64 * j] = w; }
}

__device__ __forceinline__ void p0_prologue(Frame& F) {
    LAS float* scr = (LAS float*)(F.lds + F.wave * 16384);
    const int gw = F.bx * NWAVES + F.wave, NGW = F.G * NWAVES;
    constexpr int I_IN = (D / 64) * (INW / 32), I_O = (D / 64) * (D / 32), I_UP = (D / 64) * (UPW / 32), I_DN = (FF / 64) * (D / 32), I_PL = 4 * 2;
    constexpr int I_LAYER = I_IN + I_O + I_UP + I_DN + I_PL;
    for (int it = gw; it < DEPTH * I_LAYER; it += NGW) {
        const int l = it / I_LAYER; int r = it % I_LAYER;
        unsigned char* wl = F.ws + WS_W + (size_t)l * W_LAYER;
        if (r < I_IN) { p0_item(F.in[2] + (size_t)l * D * INW, D, INW, F.in[1] + l * D, (bf16*)(wl + W_IN), 0, scr, r, F.lane); continue; } r -= I_IN;
        if (r < I_O) { p0_item(F.in[7] + (size_t)l * D * D, D, D, nullptr, (bf16*)(wl + W_O), 0, scr, r, F.lane); continue; } r -= I_O;
        if (r < I_UP) { p0_item(F.in[10] + (size_t)l * D * UPW, D, UPW, F.in[9] + l * D, (bf16*)(wl + W_UP), 1, scr, r, F.lane); continue; } r -= I_UP;
        if (r < I_DN) { p0_item(F.in[13] + (size_t)l * FF * D, FF, D, nullptr, (bf16*)(wl + W_DN), 0, scr, r, F.lane); continue; } r -= I_DN;
        { const int g = r >> 1; p0_item(F.in[3] + (size_t)(l * 4 + g) * 4096, 64, 64, nullptr, (bf16*)(F.ws + WS_POOLT) + (size_t)(l * 4 + g) * 4096, 0, scr, r & 1, F.lane); }
    }
    bf16* XN = (bf16*)(F.ws + WS_XN);
    float* RS = (float*)(F.ws + WS_RSTD);
    for (int m = gw; m < M; m += NGW) x_row_to_bf16(F.lane, F.in[0] + (size_t)m * D, XN + (size_t)m * D, RS + m);
}

__device__ __forceinline__ void post_rows(Frame& F, const bf16* Y, bf16* XB, const float* gain, float* RS, float* fout) {
    const int gw = F.bx * NWAVES + F.wave, NGW = F.G * NWAVES;
    f32x4 gv[4];
#pragma unroll
    for (int j = 0; j < 4; ++j) gv[j] = ((const f32x4*)gain)[F.lane + 64 * j];
    for (int m = gw; m < M; m += NGW) {
        const v2u* yr = (const v2u*)(Y + (size_t)m * D) + F.lane;
        v2u* br = (v2u*)(XB + (size_t)m * D) + F.lane;
        f32x4 yv[4], xv[4]; float s = 0.f;
#pragma unroll
        for (int j = 0; j < 4; ++j) { const v2u w = yr[64 * j], b = br[64 * j]; xv[j] = (f32x4){bf_lo(b.x), bf_hi(b.x), bf_lo(b.y), bf_hi(b.y)}; yv[j] = (f32x4){bf_lo(w.x), bf_hi(w.x), bf_lo(w.y), bf_hi(w.y)};
            s += (yv[j].x * yv[j].x + yv[j].y * yv[j].y) + (yv[j].z * yv[j].z + yv[j].w * yv[j].w); }
        const float rstd = 1.0f / sqrtf(wave_sum(s, F.lane) * (1.f / D) + EPS);
        float s2 = 0.f;
#pragma unroll
        for (int j = 0; j < 4; ++j) { xv[j] = xv[j] + yv[j] * rstd * gv[j];
            s2 += (xv[j].x * xv[j].x + xv[j].y * xv[j].y) + (xv[j].z * xv[j].z + xv[j].w * xv[j].w); }
        if (fout) {
            f32x4* orow = (f32x4*)(fout + (size_t)m * D) + F.lane;
#pragma unroll
            for (int j = 0; j < 4; ++j) orow[64 * j] = xv[j];
        } else {
            const float r2 = 1.0f / sqrtf(wave_sum(s2, F.lane) * (1.f / D) + EPS);
            if (F.lane == 0) RS[m] = r2;
#pragma unroll
            for (int j = 0; j < 4; ++j) { v2u w; w.x = pk2(xv[j].x, xv[j].y); w.y = pk2(xv[j].z, xv[j].w); br[64 * j] = w; }
        }
    }
}

__device__ __forceinline__ void ld8(const bf16* p, float (&v)[8]) {
    const v4u w = *(const v4u*)p;
    v[0] = bf_lo(w.x); v[1] = bf_hi(w.x); v[2] = bf_lo(w.y); v[3] = bf_hi(w.y); v[4] = bf_lo(w.z); v[5] = bf_hi(w.z); v[6] = bf_lo(w.w); v[7] = bf_hi(w.w);
}
constexpr int KS_STRIDE = 72, VT_STRIDE = 264, VT_OFF = 256 * KS_STRIDE * 2;
__device__ __forceinline__ void attn_unit(Frame& F, int b, int nb, int hk, const bf16* PROJ, bf16* MIX, const float* sinks) {
    LAS bf16* Ks = (LAS bf16*)F.lds; LAS bf16* Vt = (LAS bf16*)(F.lds + VT_OFF);
    const int lane = F.lane, r = lane & 31, h = lane >> 5;
#pragma unroll
    for (int i = 0; i < 4; ++i) {
        const int idx = F.tid + 512 * i, row = idx >> 3, ch = idx & 7;
        int pos = nb * 128 - 128 + row; if (pos < 0) pos += 128;
        const bf16* src = PROJ + (size_t)(b * SEQ + pos) * INW + hk * 64 + ch * 8;
        const v4u kv = *(const v4u*)(src + C_K), vv = *(const v4u*)(src + C_V);
        *(LAS v4u*)(Ks + row * KS_STRIDE + ch * 8) = kv;
        LAS bf16* vd = Vt + (ch * 8) * VT_STRIDE + row;
        vd[0 * VT_STRIDE] = (bf16)(vv.x & 0xffffu); vd[1 * VT_STRIDE] = (bf16)(vv.x >> 16);
        vd[2 * VT_STRIDE] = (bf16)(vv.y & 0xffffu); vd[3 * VT_STRIDE] = (bf16)(vv.y >> 16);
        vd[4 * VT_STRIDE] = (bf16)(vv.z & 0xffffu); vd[5 * VT_STRIDE] = (bf16)(vv.z >> 16);
        vd[6 * VT_STRIDE] = (bf16)(vv.w & 0xffffu); vd[7 * VT_STRIDE] = (bf16)(vv.w >> 16);
    }
    __syncthreads();
    const int g = F.wave >> 1, head = hk * 4 + g;
    const float sink2 = sinks[head] * LOG2E;
    for (int qq = 0; qq < 2; ++qq) {
        const int qt = 2 * (F.wave & 1) + qq, i0 = 32 * qt;
        const size_t qrow = (size_t)b * SEQ + nb * 128 + i0 + r;
        bf16x8 qf[4];
#pragma unroll
        for (int ks = 0; ks < 4; ++ks) qf[ks] = *(const bf16x8*)(PROJ + qrow * INW + C_Q + head * 64 + 16 * ks + 8 * h);
        f32x16 s[5];
#pragma unroll
        for (int kt = 0; kt < 5; ++kt) {
            f32x16 a = {};
#pragma unroll
            for (int ks = 0; ks < 4; ++ks) { const bf16x8 kf = *(const LAS bf16x8*)(Ks + (32 * (qt + kt) + r) * KS_STRIDE + 16 * ks + 8 * h); a = MFMA32(kf, qf[ks], a); }
            s[kt] = a;
        }
        const int iq = i0 + r; float mx = -1e30f;
#pragma unroll
        for (int kt = 0; kt < 5; ++kt)
#pragma unroll
            for (int i = 0; i < 16; ++i) { const int j = 32 * (qt + kt) + crow(i, h);
                const bool valid = (j > iq) && (j <= iq + 128) && (nb > 0 || j >= 128);
                const float v = valid ? s[kt][i] * (0.125f * LOG2E) : -1e30f; s[kt][i] = v; mx = fmaxf(mx, v); }
        mx = fmaxf(mx, lane_xor(mx, lane, 32)); mx = fmaxf(mx, sink2);
        float sum = 0.f;
#pragma unroll
        for (int kt = 0; kt < 5; ++kt)
#pragma unroll
            for (int i = 0; i < 16; ++i) { const float p = __builtin_amdgcn_exp2f(s[kt][i] - mx); s[kt][i] = p; sum += p; }
        sum += lane_xor(sum, lane, 32); sum += __builtin_amdgcn_exp2f(sink2 - mx);
        const float inv = 1.0f / sum;
        f32x16 o[2] = {{}, {}};
#pragma unroll
        for (int kt = 0; kt < 5; ++kt)
#pragma unroll
            for (int st = 0; st < 2; ++st) {
                v4u pw; pw.x = pk2(s[kt][8 * st + 0], s[kt][8 * st + 1]); pw.y = pk2(s[kt][8 * st + 2], s[kt][8 * st + 3]);
                pw.z = pk2(s[kt][8 * st + 4], s[kt][8 * st + 5]); pw.w = pk2(s[kt][8 * st + 6], s[kt][8 * st + 7]);
                const bf16x8 pb = __builtin_bit_cast(bf16x8, pw);
#pragma unroll
                for (int db = 0; db < 2; ++db) {
                    const LAS bf16* vp = Vt + (32 * db + r) * VT_STRIDE + 32 * (qt + kt) + 16 * st + 4 * h;
                    const s16x4 lo = *(const LAS s16x4*)vp, hi = *(const LAS s16x4*)(vp + 8);
                    const bf16x8 va = __builtin_shufflevector(lo, hi, 0, 1, 2, 3, 4, 5, 6, 7);
                    o[db] = MFMA32(va, pb, o[db]);
                }
            }
        bf16* orow = MIX + qrow * D + 512 + head * 64;
#pragma unroll
        for (int db = 0; db < 2; ++db)
#pragma unroll
            for (int g4 = 0; g4 < 4; ++g4) { v2u w; w.x = pk2(o[db][4 * g4] * inv, o[db][4 * g4 + 1] * inv); w.y = pk2(o[db][4 * g4 + 2] * inv, o[db][4 * g4 + 3] * inv);
                *(v2u*)(orow + 32 * db + 8 * g4 + 4 * h) = w; }
    }
    __syncthreads();
}

constexpr int DL_STRIDE = 264;
__device__ __forceinline__ void pc_unit(Frame& F, int tok0, int l, const bf16* PROJ, bf16* MIX) {
    LAS bf16* Dl = (LAS bf16*)F.lds;
    const int s0 = tok0 % SEQ;
    const float* cw = F.in[5] + (size_t)l * 3 * 256;
#pragma unroll 1
    for (int i = 0; i < 4; ++i) {
        const int idx = F.tid + 512 * i, tk = idx >> 5, ch = idx & 31, grp = ch >> 3, w = 2 << grp;
        const int s = s0 + tk; const size_t row = (size_t)tok0 + tk;
        float u[8], acc[8]; ld8(PROJ + row * INW + ch * 8, u);
#pragma unroll
        for (int e = 0; e < 8; ++e) acc[e] = u[e];
        const int n = (s + 1 < w) ? s + 1 : w;
        for (int k = 1; k < n; ++k) { float t[8]; ld8(PROJ + (row - k) * INW + ch * 8, t);
#pragma unroll
            for (int e = 0; e < 8; ++e) acc[e] += t[e]; }
        const float rn = 1.0f / (float)n;
        v4u dw; dw.x = pk2(acc[0] * rn - u[0], acc[1] * rn - u[1]); dw.y = pk2(acc[2] * rn - u[2], acc[3] * rn - u[3]);
        dw.z = pk2(acc[4] * rn - u[4], acc[5] * rn - u[5]); dw.w = pk2(acc[6] * rn - u[6], acc[7] * rn - u[7]);
        *(LAS v4u*)(Dl + tk * DL_STRIDE + ch * 8) = dw;
        float y[8];
#pragma unroll
        for (int e = 0; e < 8; ++e) y[e] = 0.f;
#pragma unroll
        for (int j = 0; j < 3; ++j) {
            if (s - 2 + j >= 0) { float gc[8], uc[8]; const bf16* p = PROJ + (row - 2 + j) * INW + ch * 8; ld8(p + C_GC, gc); ld8(p + C_UC, uc);
                const f32x4 wa = *(const f32x4*)(cw + j * 256 + ch * 8), wb = *(const f32x4*)(cw + j * 256 + ch * 8 + 4);
#pragma unroll
                for (int e = 0; e < 4; ++e) { y[e] += wa[e] * gc[e] * uc[e]; y[4 + e] += wb[e] * gc[4 + e] * uc[4 + e]; } }
        }
        float gb[8]; ld8(PROJ + row * INW + C_GB + ch * 8, gb);
        v4u ow; ow.x = pk2(gb[0] * y[0], gb[1] * y[1]); ow.y = pk2(gb[2] * y[2], gb[3] * y[3]); ow.z = pk2(gb[4] * y[4], gb[5] * y[5]); ow.w = pk2(gb[6] * y[6], gb[7] * y[7]);
        *(v4u*)(MIX + row * D + 256 + ch * 8) = ow;
    }
    __syncthreads();
    {
        const int lane = F.lane, r = lane & 31, h = lane >> 5, tt = F.wave & 1, grp = F.wave >> 1;
        const bf16* PT = (const bf16*)(F.ws + WS_POOLT) + (size_t)(l * 4 + grp) * 4096;
        const float* psc = F.in[4] + (size_t)l * 256 + grp * 64;
        bf16x8 df[4];
#pragma unroll
        for (int ks = 0; ks < 4; ++ks) df[ks] = *(const LAS bf16x8*)(Dl + (32 * tt + r) * DL_STRIDE + 64 * grp + 16 * ks + 8 * h);
#pragma unroll
        for (int db = 0; db < 2; ++db) {
            f32x16 a = {};
#pragma unroll
            for (int ks = 0; ks < 4; ++ks) { const bf16x8 wf = *(const bf16x8*)(PT + (32 * db + r) * 64 + 16 * ks + 8 * h); a = MFMA32(wf, df[ks], a); }
            bf16* orow = MIX + ((size_t)tok0 + 32 * tt + r) * D + grp * 64 + 32 * db;
#pragma unroll
            for (int g4 = 0; g4 < 4; ++g4) { const f32x4 sc = *(const f32x4*)(psc + 32 * db + 8 * g4 + 4 * h);
                v2u w; w.x = pk2(a[4 * g4] * sc[0], a[4 * g4 + 1] * sc[1]); w.y = pk2(a[4 * g4 + 2] * sc[2], a[4 * g4 + 3] * sc[3]);
                *(v2u*)(orow + 8 * g4 + 4 * h) = w; }
        }
    }
    __syncthreads();
}

__device__ __forceinline__ void mixer_phase(Frame& F, int l) {
    const bf16* PROJ = (const bf16*)(F.ws + WS_PROJ); bf16* MIX = (bf16*)(F.ws + WS_MIX);
    const float* sinks = F.in[6] + l * 8;
    for (int u = F.bx; u < BATCH * 32 * 2; u += F.G) { const int hk = u & 1, nb = (u >> 1) & 31, b = u >> 6; attn_unit(F, b, nb, hk, PROJ, MIX, sinks); }
    for (int u = F.bx; u < M / 64; u += F.G) pc_unit(F, u * 64, l, PROJ, MIX);
}

__device__ __forceinline__ void fixup_phase(Frame& F, int l) {
    const float* head = (const float*)(F.ws + WS_HEAD); const float* tail = (const float*)(F.ws + WS_TAIL);
    const float* cw = F.in[11] + (size_t)l * 3 * UPW; const float* cb = F.in[12] + (size_t)l * UPW;
    bf16* H = (bf16*)(F.ws + WS_H);
    const int nth = F.G * NWAVES * 64;
    for (int idx = F.bx * (NWAVES * 64) + F.tid; idx < 128 * 2 * (FF / 4); idx += nth) {
        const int pm = idx / (2 * (FF / 4)), rem = idx % (2 * (FF / 4)), r = rem / (FF / 4), f = 4 * (rem % (FF / 4));
        if ((pm & 15) == 0) continue;
        f32x4 y[2];
#pragma unroll
        for (int hf = 0; hf < 2; ++hf) { const int c = hf * FF + f;
            const f32x4 cur = *(const f32x4*)(head + ((size_t)pm * 2 + r) * UPW + c);
            const f32x4 t0 = *(const f32x4*)(tail + ((size_t)(pm - 1) * 2 + 0) * UPW + c), t1 = *(const f32x4*)(tail + ((size_t)(pm - 1) * 2 + 1) * UPW + c);
            const f32x4 h0 = *(const f32x4*)(head + ((size_t)pm * 2 + 0) * UPW + c);
            const f32x4 p1 = r == 0 ? t1 : h0, p2 = r == 0 ? t0 : t1;
            const f32x4 w0 = *(const f32x4*)(cw + c), w1 = *(const f32x4*)(cw + UPW + c), w2 = *(const f32x4*)(cw + 2 * UPW + c), bb = *(const f32x4*)(cb + c);
            y[hf] = w2 * cur + w1 * p1 + w0 * p2 + bb; }
        float hv[4];
#pragma unroll
        for (int j = 0; j < 4; ++j) { const float g = y[0][j]; hv[j] = g * __builtin_amdgcn_rcpf(1.0f + __builtin_amdgcn_exp2f(-LOG2E * g)) * y[1][j]; }
        v2u w; w.x = pk2(hv[0], hv[1]); w.y = pk2(hv[2], hv[3]);
        *(v2u*)(H + ((size_t)pm * 256 + r) * FF + f) = w;
    }
}

#ifndef MK_MULTI
#define MK_MULTI 0
#endif
constexpr int N_PHASES = 1 + 8 * DEPTH;
struct Args { const float* in[15]; float* out; unsigned char* ws; int ph_lo, ph_hi; };
__global__ void __launch_bounds__(NWAVES * 64, 2) mk_fwd(Args args) {
    extern __shared__ __attribute__((aligned(16))) unsigned char lds[];
    cg::grid_group grid = cg::this_grid();
    int tid_c = threadIdx.x; unsigned char* ws_c = args.ws;
    for (int ph = args.ph_lo; ph < args.ph_hi; ++ph) {
        Frame F;
        asm volatile("" : "+v"(tid_c)); F.tid = tid_c;
        asm volatile("" : "+s"(ws_c)); F.ws = ws_c;
        F.lds = (LAS unsigned char*)lds;
        F.lane = F.tid & 63; F.wave = __builtin_amdgcn_readfirstlane(F.tid >> 6);
        F.G = gridDim.x; F.bx = blockIdx.x;
#pragma unroll
        for (int i = 0; i < 15; ++i) F.in[i] = args.in[i];
        F.out = args.out;
        bf16* XN = (bf16*)(F.ws + WS_XN); bf16* PROJ = (bf16*)(F.ws + WS_PROJ); bf16* MIX = (bf16*)(F.ws + WS_MIX); bf16* HB = (bf16*)(F.ws + WS_H); bf16* Y = (bf16*)(F.ws + WS_Y);
        if (ph == 0) { p0_prologue(F); }
        else {
            const int l = (ph - 1) >> 3, k = (ph - 1) & 7;
            unsigned char* wl = F.ws + WS_W + (size_t)l * W_LAYER;
            if (k == 0 || k == 2 || k == 6) {
                pg8::Gemm g; pg8::EpiBf16 E;
                if (k == 0) { g = pg8::Gemm{XN, (const bf16*)(wl + W_IN), M, INW, D}; E = pg8::EpiBf16{PROJ, INW, (const float*)(F.ws + WS_RSTD)}; }
                else if (k == 2) { g = pg8::Gemm{MIX, (const bf16*)(wl + W_O), M, D, D}; E = pg8::EpiBf16{Y, D}; }
                else { g = pg8::Gemm{HB, (const bf16*)(wl + W_DN), M, D, FF}; E = pg8::EpiBf16{Y, D, nullptr}; }
                pg8::StaticOrder S; S.init(M, g.N, F.G, F.bx);
                pg8::gemm_phase<pg8::EpiBf16, pg8::StaticOrder, true, true>(F.lds, g, S, E, F.tid);
            } else if (k == 1) {
                mixer_phase(F, l);
            } else if (k == 3 || k == 7) {
                const float* gain = (k == 3 ? F.in[8] : F.in[14]) + (size_t)l * D;
                post_rows(F, Y, XN, gain, (float*)(F.ws + WS_RSTD), (k == 7 && l == DEPTH - 1) ? F.out : (float*)nullptr);
            } else if (k == 4) {
                pg8::Gemm g{XN, (const bf16*)(wl + W_UP), M, UPW, D};
                pg8::EpiUpConv E{HB, F.in[11] + (size_t)l * 3 * UPW, F.in[12] + (size_t)l * UPW, (float*)(F.ws + WS_HEAD), (float*)(F.ws + WS_TAIL), (PG8_LAS float*)(F.lds + BND_OFF), (const float*)(F.ws + WS_RSTD)};
                pg8::StaticOrder S; S.init(M, UPW, F.G, F.bx);
                pg8::gemm_phase<pg8::EpiUpConv, pg8::StaticOrder, true, true>(F.lds, g, S, E, F.tid);
            } else {
                fixup_phase(F, l);
            }
        }
        if (ph + 1 < args.ph_hi) grid.sync();
    }
}

extern "C" void kernel_launch(void* const* d_in, const int* in_sizes, int n_in, void* d_out, int out_size, void* d_ws, size_t ws_size, hipStream_t stream) {
    static int grid = 0;
    if (grid == 0) {
        if (n_in != 15 || out_size != M * D || ws_size < WS_END) { fprintf(stderr, "kernel_launch: unexpected problem (n_in %d, out %d, ws %zu); nothing launched\n", n_in, out_size, ws_size); grid = -1; return; }
        int dev = 0, cus = 0, per_cu = 0;
        if (hipGetDevice(&dev) != hipSuccess || hipDeviceGetAttribute(&cus, hipDeviceAttributeMultiprocessorCount, dev) != hipSuccess) { grid = -1; return; }
        if (hipFuncSetAttribute((const void*)mk_fwd, hipFuncAttributeMaxDynamicSharedMemorySize, LDS_BYTES) != hipSuccess) { fprintf(stderr, "kernel_launch: hipFuncSetAttribute failed\n"); grid = -1; return; }
        if (hipOccupancyMaxActiveBlocksPerMultiprocessor(&per_cu, (const void*)mk_fwd, NWAVES * 64, LDS_BYTES) != hipSuccess || per_cu < 1) { fprintf(stderr, "kernel_launch: occupancy query says %d\n", per_cu); per_cu = 1; }
        (void)hipGetLastError();
        grid = cus * per_cu;
    }
    if (grid < 0) return;
    Args a{};
    for (int i = 0; i < 15; ++i) a.in[i] = (const float*)d_in[i];
    a.out = (float*)d_out; a.ws = (unsigned char*)d_ws;
#if MK_MULTI
    for (int ph = 0; ph < N_PHASES; ++ph) { a.ph_lo = ph; a.ph_hi = ph + 1; hipLaunchKernelGGL(mk_fwd, dim3(grid), dim3(NWAVES * 64), LDS_BYTES, stream, a); }
#else
    a.ph_lo = 0; a.ph_hi = N_PHASES;
    void* kargs[] = {&a};
    hipError_t e = hipLaunchCooperativeKernel((const void*)mk_fwd, dim3(grid), dim3(NWAVES * 64), kargs, LDS_BYTES, stream);
    if (e != hipSuccess) fprintf(stderr, "kernel_launch: cooperative launch failed: %s (grid %d)\n", hipGetErrorString(e), grid);
#endif
}
```

```cpp
#include <hip/hip_runtime.h>
#include <hip/hip_cooperative_groups.h>
#include <cstdio>
#include <cstdint>
namespace cg = cooperative_groups;
namespace pg8 {
#define PG8_LAS __attribute__((address_space(3)))
typedef unsigned short bf16_t;
typedef short bf16x8 __attribute__((ext_vector_type(8)));
typedef float f32x4 __attribute__((ext_vector_type(4)));
typedef unsigned u32x4 __attribute__((ext_vector_type(4)));
constexpr int BM = 256, BK = 64, HALF = 128, HTB = HALF * BK * 2  , STAGE_BYTES = 8 * HTB, NXCD = 8, WGM = 8;

__host__ __device__ __forceinline__ int lds_byte(int r, int c) { const int st = (r >> 4) * 2 + (c >> 5), rr = r & 15, cc = c & 31, ob = rr * 64 + cc * 2; return st * 1024 + (ob ^ (((ob >> 9) & 1) << 5)); }
__host__ __device__ __forceinline__ void stage_rc(int b, int& R, int& C) { const int st = b / 1024, sb = b % 1024, swz = sb ^ (((sb >> 9) & 1) << 5); R = (st >> 1) * 16 + swz / 64; C = (st & 1) * 32 + (swz % 64) / 2; }
__host__ __device__ __forceinline__ int perm32(int rho) { const int n = rho >> 4, i = rho & 15; return 8 * (i >> 2) + 4 * n + (i & 3); }

struct Unit { int pm, pn; };
struct Gemm { const bf16_t* A; const bf16_t* Bt; int M, N, K; };

struct StaticOrder {
    int nM, nN, nwg, G, c;
    __host__ __device__ void init(int M, int N, int G_, int c_) { nM = M / BM; nN = N / BM; nwg = nM * nN; G = G_; c = c_; }
    __host__ __device__ bool next(int i, Unit& u) const {
        const long L = (long)i * G + c; if (L >= nwg) return false;
        int wgid = (int)L; { const int q = nwg / NXCD, r = nwg % NXCD, xcd = wgid % NXCD, off = wgid / NXCD; wgid = (xcd < r ? xcd * (q + 1) : r * (q + 1) + (xcd - r) * q) + off; }
        const int nig = WGM * nN, gid = wgid / nig, fm = gid * WGM, gsz = (nM - fm) < WGM ? (nM - fm) : WGM;
        u.pm = fm + ((wgid % nig) % gsz); u.pn = (wgid % nig) / gsz; return true;
    }
    __device__ __forceinline__ void a_ready(const Unit&) const {}
    __device__ __forceinline__ void done(const Unit&) const {}
};

__device__ __forceinline__ unsigned cvt_pk_bf16(float lo, float hi) { unsigned r; asm volatile("v_cvt_pk_bf16_f32 %0, %1, %2" : "=v"(r) : "v"(lo), "v"(hi)); return r; }
typedef float f32x2 __attribute__((ext_vector_type(2)));
typedef unsigned u32x2 __attribute__((ext_vector_type(2)));
struct EpiBf16 {
    static constexpr bool PERM = true, AFTER_DRAIN = false;
    bf16_t* O; int ldc; const float* rs;
    __device__ __forceinline__ void operator()(f32x4 (&acc)[2][2][4][2], const Unit& u, int wr, int wc, int fr, int fq) const {
        const int row0 = u.pm * BM + wr * 64 + fr; const int col0 = u.pn * BM + wc * 32 + 8 * fq;
#pragma unroll
        for (int ai = 0; ai < 2; ++ai)
#pragma unroll
            for (int m = 0; m < 4; ++m) { bf16_t* rowp = O + (size_t)(row0 + ai * HALF + m * 16) * ldc + col0;
                const float sc = rs ? rs[row0 + ai * HALF + m * 16] : 1.0f;
#pragma unroll
                for (int bj = 0; bj < 2; ++bj) { const f32x4 v0 = acc[ai][bj][m][0] * sc, v1 = acc[ai][bj][m][1] * sc;
                    u32x4 w; w.x = cvt_pk_bf16(v0[0], v0[1]); w.y = cvt_pk_bf16(v0[2], v0[3]); w.z = cvt_pk_bf16(v1[0], v1[1]); w.w = cvt_pk_bf16(v1[2], v1[3]);
                    *(u32x4*)(rowp + bj * HALF) = w; } }
    }
};

#ifndef ROT_DPP
#define ROT_DPP 0
#endif
__device__ __forceinline__ float rot_lane1(float v) { return __builtin_bit_cast(float, __builtin_amdgcn_update_dpp(0, __builtin_bit_cast(int, v), 0x121, 0xf, 0xf, false)); }
__device__ __forceinline__ float rot_lane2(float v) { return __builtin_bit_cast(float, __builtin_amdgcn_update_dpp(0, __builtin_bit_cast(int, v), 0x122, 0xf, 0xf, false)); }
struct EpiUpConv {
    static constexpr bool PERM = true, AFTER_DRAIN = false;
    static constexpr int FF = 2816, UPW = 5632;
    bf16_t* H; const float* cw; const float* cb; float* head; float* tail; PG8_LAS float* bnd; const float* rs;
    __device__ __forceinline__ void operator()(f32x4 (&acc)[2][2][4][2], const Unit& u, int wr, int wc, int fr, int fq) const {
#pragma unroll
        for (int ai = 0; ai < 2; ++ai)
#pragma unroll
            for (int m = 0; m < 4; ++m) { const float sc = rs[u.pm * BM + ai * HALF + wr * 64 + m * 16 + fr];
#pragma unroll
                for (int bj = 0; bj < 2; ++bj)
#pragma unroll
                    for (int n = 0; n < 2; ++n) acc[ai][bj][m][n] *= sc; }
        const int xcol = wc * 32 + 8 * fq;
        const int fcol = u.pn * 128 + xcol;
        if (fr >= 14) {
#pragma unroll
            for (int ai = 0; ai < 2; ++ai)
#pragma unroll
                for (int bj = 0; bj < 2; ++bj)
#pragma unroll
                    for (int n = 0; n < 2; ++n) *(PG8_LAS f32x4*)(bnd + ((2 * ai + wr) * 2 + (fr - 14)) * 256 + bj * 128 + xcol + 4 * n) = acc[ai][bj][3][n];
        }
        if (wr == 0 && fr < 2) {
#pragma unroll
            for (int bj = 0; bj < 2; ++bj)
#pragma unroll
                for (int n = 0; n < 2; ++n) *(f32x4*)(head + ((size_t)u.pm * 2 + fr) * UPW + bj * FF + fcol + 4 * n) = acc[0][bj][0][n];
        }
        if (wr == 1 && fr >= 14) {
#pragma unroll
            for (int bj = 0; bj < 2; ++bj)
#pragma unroll
                for (int n = 0; n < 2; ++n) *(f32x4*)(tail + ((size_t)u.pm * 2 + (fr - 14)) * UPW + bj * FF + fcol + 4 * n) = acc[1][bj][3][n];
        }
        asm volatile("s_waitcnt lgkmcnt(0)" ::: "memory"); __builtin_amdgcn_s_barrier(); asm volatile("" ::: "memory");
        u32x2 pk0[2][4];
#pragma unroll
        for (int n = 0; n < 2; ++n) {
            f32x4 w0[2], w1[2], w2[2], bb[2];
#pragma unroll
            for (int bj = 0; bj < 2; ++bj) { const int c = bj * FF + fcol + 4 * n;
                w0[bj] = *(const f32x4*)(cw + c); w1[bj] = *(const f32x4*)(cw + UPW + c); w2[bj] = *(const f32x4*)(cw + 2 * UPW + c); bb[bj] = *(const f32x4*)(cb + c); }
#pragma unroll
            for (int ai = 0; ai < 2; ++ai) {
                const int blk = 2 * ai + wr;
                f32x4 y[2][4];
#pragma unroll
                for (int bj = 0; bj < 2; ++bj) {
                    f32x4 pr1 = (f32x4){0.f, 0.f, 0.f, 0.f}, pr2 = (f32x4){0.f, 0.f, 0.f, 0.f};
                    if (blk > 0) {
                        pr1 = *(const PG8_LAS f32x4*)(bnd + ((blk - 1) * 2 + 1) * 256 + bj * 128 + xcol + 4 * n);
                        pr2 = *(const PG8_LAS f32x4*)(bnd + ((blk - 1) * 2 + (fr == 0 ? 0 : 1)) * 256 + bj * 128 + xcol + 4 * n);
                    }
#pragma unroll
                    for (int m = 0; m < 4; ++m) {
                        const f32x4 cur = acc[ai][bj][m][n]; f32x4 r1, r2;
#pragma unroll
                        for (int j = 0; j < 4; ++j) { r1[j] = rot_lane1(cur[j]); r2[j] = rot_lane2(cur[j]); }
                        const f32x4 p1 = fr >= 1 ? r1 : pr1, p2 = fr >= 2 ? r2 : pr2;
                        y[bj][m] = w2[bj] * cur + w1[bj] * p1 + w0[bj] * p2 + bb[bj];
                        pr1 = r1; pr2 = r2;
                    }
                }
#pragma unroll
                for (int m = 0; m < 4; ++m) {
                    f32x4 hv;
#pragma unroll
                    for (int j = 0; j < 4; ++j) { const float g = y[0][m][j]; hv[j] = g * __builtin_amdgcn_rcpf(1.0f + __builtin_amdgcn_exp2f(-1.4426950408889634f * g)) * y[1][m][j]; }
                    if (n == 0) { pk0[ai][m].x = cvt_pk_bf16(hv[0], hv[1]); pk0[ai][m].y = cvt_pk_bf16(hv[2], hv[3]); }
                    else { u32x4 w; w.x = pk0[ai][m].x; w.y = pk0[ai][m].y; w.z = cvt_pk_bf16(hv[0], hv[1]); w.w = cvt_pk_bf16(hv[2], hv[3]);
                        const int row = u.pm * BM + ai * HALF + wr * 64 + m * 16 + fr;
                        *(u32x4*)(H + (size_t)row * FF + fcol) = w; }
                }
            }
        }
    }
};

template <class Epi, class Sched, bool ALIGN_EPI = false, bool SP2 = false>
__device__ __forceinline__ void gemm_phase(PG8_LAS unsigned char* lds, const Gemm g, const Sched& S, const Epi& E, const int tid) {
    const int wid = __builtin_amdgcn_readfirstlane(tid >> 6), lane = tid & 63, wr = wid >> 2, wc = wid & 3, fr = lane & 15, fq = lane >> 4;
    const int K = g.K, nt = K / BK;
    unsigned voffA[2], voffB[2];
#pragma unroll
    for (int i = 0; i < 2; ++i) { int R, C; stage_rc(tid * 16 + i * 8192, R, C); const int Rb = Epi::PERM ? ((R & ~31) + perm32(R & 31)) : R;
        voffA[i] = (unsigned)(R * K + C) * 2u; voffB[i] = (unsigned)(Rb * K + C) * 2u; }
    const size_t kstep = (size_t)(BK * 2);
    const size_t hstep = (size_t)HALF * K * 2;
    const size_t tstep = 2 * hstep;
    const unsigned ldsw = (unsigned)wid * 1024u;
    const int aoff = lds_byte(wr * 64 + fr, fq * 8), boff = lds_byte(wc * 32 + fr, fq * 8);
#define PG8_SA(b, h) (((b) * 2 + (h)) * HTB)
#define PG8_SB(b, h) ((4 + (b) * 2 + (h)) * HTB)
#define PG8_STAGE(bufoff, gbase, voff) do { _Pragma("unroll") for (int _i = 0; _i < 2; ++_i) \
        __builtin_amdgcn_global_load_lds((const unsigned*)((const char*)(gbase) + (voff)[_i]), (PG8_LAS unsigned*)(lds + (bufoff) + ldsw + _i * 8192), 16, 0, 0); } while (0)
#define PG8_LDA(dst, b, h) do { _Pragma("unroll") for (int m = 0; m < 4; ++m) _Pragma("unroll") for (int k = 0; k < 2; ++k) dst[m][k] = *(const PG8_LAS bf16x8*)(lds + PG8_SA(b, h) + aoff + m * 2048 + k * 1024); } while (0)
#define PG8_LDB(dst, b, h) do { _Pragma("unroll") for (int n = 0; n < 2; ++n) _Pragma("unroll") for (int k = 0; k < 2; ++k) dst[n][k] = *(const PG8_LAS bf16x8*)(lds + PG8_SB(b, h) + boff + n * 2048 + k * 1024); } while (0)
#define PG8_MMA(ai, bj, At, Bt) do { __builtin_amdgcn_s_setprio(1); _Pragma("unroll") for (int m = 0; m < 4; ++m) _Pragma("unroll") for (int n = 0; n < 2; ++n) _Pragma("unroll") for (int k = 0; k < 2; ++k) \
        acc[ai][bj][m][n] = __builtin_amdgcn_mfma_f32_16x16x32_bf16(Bt[n][k], At[m][k], acc[ai][bj][m][n], 0, 0, 0); __builtin_amdgcn_s_setprio(0); } while (0)
#define PG8_WAIT_V(n) asm volatile("s_waitcnt vmcnt(" #n ")" ::: "memory")
#define PG8_WAIT_L(n) asm volatile("s_waitcnt lgkmcnt(" #n ")" ::: "memory")
#define PG8_BAR __builtin_amdgcn_s_barrier()
#define PG8_SCHED __builtin_amdgcn_sched_barrier(0)
    Unit cur, nxt; int ui = 0;
    if (!S.next(0, cur)) return;
    f32x4 acc[2][2][4][2];
#pragma unroll
    for (int a = 0; a < 2; ++a)
#pragma unroll
        for (int b = 0; b < 2; ++b)
#pragma unroll
            for (int m = 0; m < 4; ++m)
#pragma unroll
                for (int n = 0; n < 2; ++n) acc[a][b][m][n] = (f32x4){0.f, 0.f, 0.f, 0.f};
    bf16x8 At[4][2], B0[2][2], B1[2][2];
    const char* cA = (const char*)g.A + (size_t)cur.pm * tstep; const char* cB = (const char*)g.Bt + (size_t)cur.pn * tstep;
    S.a_ready(cur);
    if constexpr (SP2) {
        PG8_STAGE(PG8_SB(0, 0), cB, voffB); PG8_STAGE(PG8_SB(0, 1), cB + hstep, voffB); PG8_STAGE(PG8_SA(0, 0), cA, voffA); PG8_STAGE(PG8_SA(0, 1), cA + hstep, voffA);
        if (wr == 1) PG8_BAR;
        PG8_WAIT_V(2); PG8_BAR;
        PG8_STAGE(PG8_SB(1, 0), cB + kstep, voffB); PG8_STAGE(PG8_SA(1, 0), cA + kstep, voffA); PG8_STAGE(PG8_SB(1, 1), cB + hstep + kstep, voffB);
        PG8_WAIT_V(6); PG8_BAR;
    } else {
        PG8_STAGE(PG8_SB(0, 0), cB, voffB); PG8_STAGE(PG8_SA(0, 0), cA, voffA); PG8_STAGE(PG8_SB(0, 1), cB + hstep, voffB); PG8_STAGE(PG8_SA(0, 1), cA + hstep, voffA);
        if (wr == 1) PG8_BAR;
        PG8_WAIT_V(4); PG8_BAR;
        PG8_STAGE(PG8_SB(1, 0), cB + kstep, voffB); PG8_STAGE(PG8_SA(1, 0), cA + kstep, voffA); PG8_STAGE(PG8_SB(1, 1), cB + hstep + kstep, voffB);
        PG8_WAIT_V(6); PG8_BAR;
    }
    for (;;) {
        const bool has_next = S.next(ui + 1, nxt);
        const char* nA = has_next ? (const char*)g.A + (size_t)nxt.pm * tstep : cA; const char* nB = has_next ? (const char*)g.Bt + (size_t)nxt.pn * tstep : cB;
        for (int t = 0; t < nt; t += 2) {
            const bool last = (t == nt - 2);
            const char* a1 = cA + (size_t)(t + 1) * kstep;
            const char* a2 = last ? nA : cA + (size_t)(t + 2) * kstep; const char* b2 = last ? nB : cB + (size_t)(t + 2) * kstep;
            const char* a3 = a2 + kstep; const char* b3 = b2 + kstep;
            if (last && has_next) S.a_ready(nxt);
            if constexpr (SP2) {
            PG8_LDB(B0, 0, 0); PG8_LDB(B1, 0, 1); PG8_SCHED; PG8_LDA(At, 0, 0); PG8_STAGE(PG8_SA(1, 1), a1 + hstep, voffA);
            PG8_WAIT_V(8); PG8_WAIT_L(0); PG8_BAR; PG8_MMA(0, 0, At, B0); PG8_MMA(0, 1, At, B1); PG8_BAR; PG8_SCHED;
            PG8_LDA(At, 0, 1); PG8_STAGE(PG8_SB(0, 0), b2, voffB); PG8_STAGE(PG8_SB(0, 1), b2 + hstep, voffB); PG8_STAGE(PG8_SA(0, 0), a2, voffA);
            PG8_WAIT_V(8); PG8_WAIT_L(0); PG8_BAR; PG8_MMA(1, 0, At, B0); PG8_MMA(1, 1, At, B1); PG8_BAR; PG8_SCHED;
            PG8_LDB(B0, 1, 0); PG8_LDB(B1, 1, 1); PG8_SCHED; PG8_LDA(At, 1, 0); PG8_STAGE(PG8_SA(0, 1), a2 + hstep, voffA);
            PG8_WAIT_V(8); PG8_WAIT_L(0); PG8_BAR; PG8_MMA(0, 0, At, B0); PG8_MMA(0, 1, At, B1); PG8_BAR; PG8_SCHED;
            PG8_LDA(At, 1, 1); PG8_STAGE(PG8_SB(1, 0), b3, voffB); PG8_STAGE(PG8_SB(1, 1), b3 + hstep, voffB); PG8_STAGE(PG8_SA(1, 0), a3, voffA);
            PG8_WAIT_V(8); PG8_WAIT_L(0); PG8_BAR; PG8_MMA(1, 0, At, B0); PG8_MMA(1, 1, At, B1); PG8_BAR; PG8_SCHED;
            } else {
            PG8_LDB(B0, 0, 0); PG8_SCHED; PG8_LDA(At, 0, 0); PG8_STAGE(PG8_SA(1, 1), a1 + hstep, voffA);
            PG8_WAIT_L(8); PG8_BAR; PG8_WAIT_L(0); PG8_MMA(0, 0, At, B0); PG8_BAR; PG8_SCHED;
            PG8_LDB(B1, 0, 1); PG8_STAGE(PG8_SB(0, 0), b2, voffB);
            PG8_BAR; PG8_WAIT_L(0); PG8_MMA(0, 1, At, B1); PG8_BAR;
            PG8_LDA(At, 0, 1); PG8_STAGE(PG8_SA(0, 0), a2, voffA);
            PG8_BAR; PG8_WAIT_L(0); PG8_MMA(1, 0, At, B0); PG8_BAR; PG8_SCHED;
            PG8_STAGE(PG8_SB(0, 1), b2 + hstep, voffB);
            PG8_WAIT_V(6); PG8_BAR; PG8_MMA(1, 1, At, B1); PG8_BAR;
            PG8_LDB(B0, 1, 0); PG8_SCHED; PG8_LDA(At, 1, 0); PG8_STAGE(PG8_SA(0, 1), a2 + hstep, voffA);
            PG8_WAIT_L(8); PG8_BAR; PG8_WAIT_L(0); PG8_MMA(0, 0, At, B0); PG8_BAR; PG8_SCHED;
            PG8_LDB(B1, 1, 1); PG8_STAGE(PG8_SB(1, 0), b3, voffB);
            PG8_BAR; PG8_WAIT_L(0); PG8_MMA(0, 1, At, B1); PG8_BAR;
            PG8_LDA(At, 1, 1); PG8_STAGE(PG8_SA(1, 0), a3, voffA);
            PG8_BAR; PG8_WAIT_L(0); PG8_MMA(1, 0, At, B0); PG8_BAR; PG8_SCHED;
            PG8_STAGE(PG8_SB(1, 1), b3 + hstep, voffB);
            PG8_WAIT_V(6); PG8_BAR; PG8_MMA(1, 1, At, B1); PG8_BAR;
            }
        }
        if constexpr (ALIGN_EPI) { if (wr == 0) PG8_BAR; }
        if constexpr (!Epi::AFTER_DRAIN) { E(acc, cur, wr, wc, fr, fq); S.done(cur); }
        if (!has_next) break;
#pragma unroll
        for (int a = 0; a < 2; ++a)
#pragma unroll
            for (int b = 0; b < 2; ++b)
#pragma unroll
                for (int m = 0; m < 4; ++m)
#pragma unroll
                    for (int n = 0; n < 2; ++n) acc[a][b][m][n] = (f32x4){0.f, 0.f, 0.f, 0.f};
        cur = nxt; cA = nA; cB = nB; ++ui;
        if constexpr (ALIGN_EPI) { if (wr == 1) PG8_BAR; }
    }
    PG8_WAIT_V(0);
    if constexpr (!ALIGN_EPI) { if (wr == 0) PG8_BAR; }
    PG8_BAR;
    if constexpr (Epi::AFTER_DRAIN) { E.fused(acc, cur, wr, wc, fr, fq, lds, wid, lane); S.done(cur); }
#undef PG8_SA
#undef PG8_SB
#undef PG8_STAGE
#undef PG8_LDA
#undef PG8_LDB
#undef PG8_MMA
#undef PG8_WAIT_V
#undef PG8_WAIT_L
#undef PG8_BAR
#undef PG8_SCHED
}
}

constexpr int NWAVES = 8;
constexpr int BATCH = 8, SEQ = 4096, D = 1024, DEPTH = 4, M = BATCH * SEQ;
constexpr int INW = 1792, FF = 2816, UPW = 2 * FF;
constexpr int C_GB = 256, C_GC = 512, C_UC = 768, C_Q = 1024, C_K = 1536, C_V = 1664;
constexpr float EPS = 1e-6f;
constexpr float LOG2E = 1.4426950408889634f;

constexpr size_t MiB = 1u << 20;
constexpr size_t WS_CTL = 0, CTL_ZERO_BYTES = 64 * 1024;
constexpr size_t WS_W = 1 * MiB;
constexpr size_t W_LAYER = 22 * MiB, W_IN = 0, W_O = (size_t)INW * D * 2, W_UP = W_O + (size_t)D * D * 2, W_DN = W_UP + (size_t)UPW * D * 2;
static_assert(W_DN + (size_t)D * FF * 2 <= W_LAYER, "weight layer map");
constexpr size_t WS_POOLT = 89 * MiB;
constexpr size_t WS_XN = 90 * MiB;
constexpr size_t WS_PROJ = 154 * MiB;
constexpr size_t WS_MIX = 266 * MiB;
constexpr size_t WS_H = 154 * MiB;
constexpr size_t WS_Y = 330 * MiB;
constexpr size_t WS_HEAD = 394 * MiB, WS_TAIL = 400 * MiB;
constexpr size_t WS_RSTD = 406 * MiB;
constexpr size_t WS_END = 407 * MiB;
static_assert(WS_PROJ + (size_t)M * INW * 2 <= WS_MIX && WS_H + (size_t)M * FF * 2 <= WS_Y && WS_HEAD + (size_t)128 * 2 * UPW * 4 <= WS_TAIL, "d_ws map");

constexpr int RING_BYTES = 131072, BND_OFF = RING_BYTES, MISC_OFF = BND_OFF + 8192, LDS_BYTES = 147456;

#define LAS __attribute__((address_space(3)))
typedef unsigned short bf16;
typedef unsigned v4u __attribute__((ext_vector_type(4)));
typedef unsigned v2u __attribute__((ext_vector_type(2)));
typedef float f32x4 __attribute__((ext_vector_type(4)));
typedef float f32x16 __attribute__((ext_vector_type(16)));
typedef short bf16x8 __attribute__((ext_vector_type(8)));
typedef short s16x4 __attribute__((ext_vector_type(4)));
#define LDS_WAIT() asm volatile("s_waitcnt lgkmcnt(0)" ::: "memory")
#define MFMA32(a, b, c) __builtin_amdgcn_mfma_f32_32x32x16_bf16((a), (b), (c), 0, 0, 0)

__device__ __forceinline__ unsigned f2bf(float f) { unsigned u = __builtin_bit_cast(unsigned, f); return (u + 0x7fffu + ((u >> 16) & 1u)) >> 16; }
__device__ __forceinline__ unsigned pk2(float lo, float hi) { return f2bf(lo) | (f2bf(hi) << 16); }
__device__ __forceinline__ float bf_lo(unsigned w) { return __builtin_bit_cast(float, w << 16); }
__device__ __forceinline__ float bf_hi(unsigned w) { return __builtin_bit_cast(float, w & 0xffff0000u); }
__device__ __forceinline__ int crow(int r, int hi) { return (r & 3) + 8 * (r >> 2) + 4 * hi; }
__device__ __forceinline__ float lane_xor(float v, int lane, int o) { return __builtin_bit_cast(float, __builtin_amdgcn_ds_bpermute((lane ^ o) << 2, __builtin_bit_cast(int, v))); }
__device__ __forceinline__ float wave_sum(float v, int lane) {
#pragma unroll
    for (int o = 1; o < 64; o <<= 1) v += lane_xor(v, lane, o);
    return v;
}

#define XB_TMO      128
#define XB_XCNT(j)  (256  + 64 * (j))
#define XB_XSUB(j)  (1280 + 64 * (j))
#define XB_XGEN(j)  (2304 + 64 * (j))
#define XB_TOP      3328
#define XB_TOPGEN   3392
#define XCD_BAR_WORDS 3456
#define XB_SPIN_CAP (1u << 18)

__device__ __forceinline__ unsigned xb_ld(unsigned* p)              { return __hip_atomic_load(p, __ATOMIC_RELAXED, __HIP_MEMORY_SCOPE_AGENT); }
__device__ __forceinline__ unsigned xb_add(unsigned* p, unsigned v) { return __hip_atomic_fetch_add(p, v, __ATOMIC_RELAXED, __HIP_MEMORY_SCOPE_AGENT); }
__device__ __forceinline__ unsigned xb_xcc_id() { return (unsigned)__builtin_amdgcn_s_getreg((3 << 11) | 20) & 0xFu; }
#define XB_SPIN(cond, bar) do { unsigned _sp = 0; while (cond) { __builtin_amdgcn_s_sleep(1); \
    if ((++_sp & 255u) == 0u) { if (xb_ld(&(bar)[XB_TMO])) break; if (_sp > XB_SPIN_CAP) { atomicAdd(&(bar)[XB_TMO], 1u); break; } } } } while (0)

struct XcdBarrier {
    unsigned* bar; unsigned x;
    volatile LAS unsigned* st;
};

__device__ __forceinline__ XcdBarrier xcd_barrier_post(unsigned* bar, volatile LAS unsigned* st) {
    XcdBarrier b; b.bar = bar; b.x = xb_xcc_id(); b.st = st;
    if (threadIdx.x == 0) (void)xb_add(&bar[XB_XCNT(b.x)], 1u);
    return b;
}
__device__ __forceinline__ void xcd_barrier_complete(unsigned* bar, unsigned x, unsigned& nloc, unsigned& nx) {
    const unsigned G = gridDim.x * gridDim.y * gridDim.z;
    unsigned sum, cnt, mine, sp = 0u;
    for (;;) {
        sum = 0u; cnt = 0u; mine = 0u;
#pragma unroll
        for (unsigned j = 0; j < 16; ++j) { const unsigned c = xb_ld(&bar[XB_XCNT(j)]); sum += c; cnt += (c > 0u) ? 1u : 0u; mine = (j == x) ? c : mine; }
        if (sum == G) break;
        __builtin_amdgcn_s_sleep(1);
        if ((++sp & 255u) == 0u) { if (xb_ld(&bar[XB_TMO])) break; if (sp > XB_SPIN_CAP) { atomicAdd(&bar[XB_TMO], 1u); break; } }
    }
    nloc = mine > 0u ? mine : 1u; nx = cnt > 0u ? cnt : 1u;
}

__device__ __forceinline__ void xcd_barrier(const XcdBarrier& b) {
    asm volatile("s_waitcnt vmcnt(0)" ::: "memory");
    __syncthreads();
    if (threadIdx.x == 0) {
        unsigned* bar = b.bar;
        __builtin_amdgcn_s_waitcnt(0);
        unsigned nloc = b.st[0], nx = b.st[1];
        if (nloc == 0u) { xcd_barrier_complete(bar, b.x, nloc, nx); b.st[0] = nloc; b.st[1] = nx; }
        const unsigned old = xb_add(&bar[XB_XSUB(b.x)], 1u);
        const unsigned gen = old / nloc;
        if (old + 1u == (gen + 1u) * nloc) {
            __builtin_amdgcn_fence(__ATOMIC_RELEASE, "agent");
            asm volatile("s_waitcnt vmcnt(0)" ::: "memory");
            const unsigned og = xb_add(&bar[XB_TOP], 1u);
            const unsigned tg = og / nx;
            if (og + 1u == (tg + 1u) * nx) xb_add(&bar[XB_TOPGEN], 1u);
            else XB_SPIN(xb_ld(&bar[XB_TOPGEN]) == tg, bar);
            __builtin_amdgcn_fence(__ATOMIC_ACQUIRE, "agent");
            xb_add(&bar[XB_XGEN(b.x)], 1u);
            asm volatile("s_waitcnt vmcnt(0)" ::: "memory");
        } else {
            XB_SPIN(xb_ld(&bar[XB_XGEN(b.x)]) == gen, bar);
            __builtin_amdgcn_fence(__ATOMIC_ACQUIRE, "agent");
            asm volatile("s_waitcnt vmcnt(0)" ::: "memory");
        }
    }
    __syncthreads();
}

struct Frame {
    LAS unsigned char* lds;
    int tid, lane, wave, G, bx;
    const float* in[15]; float* out; unsigned char* ws;
};

__device__ __forceinline__ void p0_item(const float* W, int K, int N, const float* gain, bf16* WT, int mode, LAS float* scr, int item, int lane) {
    const int nblk = N / 32, kb = item / nblk, nb = item % nblk, k0 = 64 * kb, n0 = 32 * nb;
#pragma unroll 8
    for (int i = 0; i < 32; ++i) { const int kk = 2 * i + (lane >> 5); const float gsc = gain ? gain[k0 + kk] : 1.0f; scr[kk * 33 + (lane & 31)] = W[(size_t)(k0 + kk) * N + n0 + (lane & 31)] * gsc; }
    LDS_WAIT(); asm volatile("" ::: "memory");
    int d0 = n0;
    if (mode == 1) { d0 = (n0 < FF) ? 256 * (n0 / 128) + (n0 % 128) : 256 * ((n0 - FF) / 128) + 128 + ((n0 - FF) % 128); }
    const int c = lane & 7;
#pragma unroll
    for (int j = 0; j < 4; ++j) { const int n = (lane >> 3) + 8 * j; const LAS float* s = scr + (8 * c) * 33 + n;
        v4u o; o.x = pk2(s[0 * 33], s[1 * 33]); o.y = pk2(s[2 * 33], s[3 * 33]); o.z = pk2(s[4 * 33], s[5 * 33]); o.w = pk2(s[6 * 33], s[7 * 33]);
        *(v4u*)(WT + (size_t)(d0 + n) * K + k0 + 8 * c) = o; }
    LDS_WAIT(); asm volatile("" ::: "memory");
}

__device__ __forceinline__ void x_row_to_bf16(int lane, const float* xrow, bf16* orow, float* rstd_out) {
    const f32x4* xr = (const f32x4*)xrow + lane;
    f32x4 v[4]; float s = 0.f;
#pragma unroll
    for (int j = 0; j < 4; ++j) { v[j] = xr[64 * j]; s += (v[j].x * v[j].x + v[j].y * v[j].y) + (v[j].z * v[j].z + v[j].w * v[j].w); }
    const float rstd = 1.0f / sqrtf(wave_sum(s, lane) * (1.f / D) + EPS);
    if (lane == 0) *rstd_out = rstd;
    v2u* o8 = (v2u*)orow + lane;
#pragma unroll
    for (int j = 0; j < 4; ++j) { v2u w; w.x = pk2(v[j].x, v[j].y); w.y = pk2(v[j].z, v[j].w); o8[64 * j] = w; }
}

__device__ __forceinline__ void p0_prologue(Frame& F) {
    LAS float* scr = (LAS float*)(F.lds + F.wave * 16384);
    const int gw = F.bx * NWAVES + F.wave, NGW = F.G * NWAVES;
    constexpr int I_IN = (D / 64) * (INW / 32), I_O = (D / 64) * (D / 32), I_UP = (D / 64) * (UPW / 32), I_DN = (FF / 64) * (D / 32), I_PL = 4 * 2;
    constexpr int I_LAYER = I_IN + I_O + I_UP + I_DN + I_PL;
    for (int it = gw; it < DEPTH * I_LAYER; it += NGW) {
        const int l = it / I_LAYER; int r = it % I_LAYER;
        unsigned char* wl = F.ws + WS_W + (size_t)l * W_LAYER;
        if (r < I_IN) { p0_item(F.in[2] + (size_t)l * D * INW, D, INW, F.in[1] + l * D, (bf16*)(wl + W_IN), 0, scr, r, F.lane); continue; } r -= I_IN;
        if (r < I_O) { p0_item(F.in[7] + (size_t)l * D * D, D, D, nullptr, (bf16*)(wl + W_O), 0, scr, r, F.lane); continue; } r -= I_O;
        if (r < I_UP) { p0_item(F.in[10] + (size_t)l * D * UPW, D, UPW, F.in[9] + l * D, (bf16*)(wl + W_UP), 1, scr, r, F.lane); continue; } r -= I_UP;
        if (r < I_DN) { p0_item(F.in[13] + (size_t)l * FF * D, FF, D, nullptr, (bf16*)(wl + W_DN), 0, scr, r, F.lane); continue; } r -= I_DN;
        { const int g = r >> 1; p0_item(F.in[3] + (size_t)(l * 4 + g) * 4096, 64, 64, nullptr, (bf16*)(F.ws + WS_POOLT) + (size_t)(l * 4 + g) * 4096, 0, scr, r & 1, F.lane); }
    }
    bf16* XN = (bf16*)(F.ws + WS_XN);
    float* RS = (float*)(F.ws + WS_RSTD);
    for (int m = gw; m < M; m += NGW) x_row_to_bf16(F.lane, F.in[0] + (size_t)m * D, XN + (size_t)m * D, RS + m);
}

__device__ __forceinline__ void post_rows(Frame& F, const bf16* Y, bf16* XB, const float* gain, float* RS, float* fout) {
    const int gw = F.bx * NWAVES + F.wave, NGW = F.G * NWAVES;
    f32x4 gv[4];
#pragma unroll
    for (int j = 0; j < 4; ++j) gv[j] = ((const f32x4*)gain)[F.lane + 64 * j];
    for (int m = gw; m < M; m += NGW) {
        const v2u* yr = (const v2u*)(Y + (size_t)m * D) + F.lane;
        v2u* br = (v2u*)(XB + (size_t)m * D) + F.lane;
        f32x4 yv[4], xv[4]; float s = 0.f;
#pragma unroll
        for (int j = 0; j < 4; ++j) { const v2u w = yr[64 * j], b = br[64 * j]; xv[j] = (f32x4){bf_lo(b.x), bf_hi(b.x), bf_lo(b.y), bf_hi(b.y)}; yv[j] = (f32x4){bf_lo(w.x), bf_hi(w.x), bf_lo(w.y), bf_hi(w.y)};
            s += (yv[j].x * yv[j].x + yv[j].y * yv[j].y) + (yv[j].z * yv[j].z + yv[j].w * yv[j].w); }
        const float rstd = 1.0f / sqrtf(wave_sum(s, F.lane) * (1.f / D) + EPS);
        float s2 = 0.f;
#pragma unroll
        for (int j = 0; j < 4; ++j) { xv[j] = xv[j] + yv[j] * rstd * gv[j];
            s2 += (xv[j].x * xv[j].x + xv[j].y * xv[j].y) + (xv[j].z * xv[j].z + xv[j].w * xv[j].w); }
        if (fout) {
            f32x4* orow = (f32x4*)(fout + (size_t)m * D) + F.lane;
#pragma unroll
            for (int j = 0; j < 4; ++j) orow[64 * j] = xv[j];
        } else {
            const float r2 = 1.0f / sqrtf(wave_sum(s2, F.lane) * (1.f / D) + EPS);
            if (F.lane == 0) RS[m] = r2;
#pragma unroll
            for (int j = 0; j < 4; ++j) { v2u w; w.x = pk2(xv[j].x, xv[j].y); w.y = pk2(xv[j].z, xv[j].w); br[64 * j] = w; }
        }
    }
}

__device__ __forceinline__ void ld8(const bf16* p, float (&v)[8]) {
    const v4u w = *(const v4u*)p;
    v[0] = bf_lo(w.x); v[1] = bf_hi(w.x); v[2] = bf_lo(w.y); v[3] = bf_hi(w.y); v[4] = bf_lo(w.z); v[5] = bf_hi(w.z); v[6] = bf_lo(w.w); v[7] = bf_hi(w.w);
}
constexpr int KS_STRIDE = 72, VT_STRIDE = 264, VT_OFF = 256 * KS_STRIDE * 2;
__device__ __forceinline__ void attn_unit(Frame& F, int b, int nb, int hk, const bf16* PROJ, bf16* MIX, const float* sinks) {
    LAS bf16* Ks = (LAS bf16*)F.lds; LAS bf16* Vt = (LAS bf16*)(F.lds + VT_OFF);
    const int lane = F.lane, r = lane & 31, h = lane >> 5;
#pragma unroll
    for (int i = 0; i < 4; ++i) {
        const int idx = F.tid + 512 * i, row = idx >> 3, ch = idx & 7;
        int pos = nb * 128 - 128 + row; if (pos < 0) pos += 128;
        const bf16* src = PROJ + (size_t)(b * SEQ + pos) * INW + hk * 64 + ch * 8;
        const v4u kv = *(const v4u*)(src + C_K), vv = *(const v4u*)(src + C_V);
        *(LAS v4u*)(Ks + row * KS_STRIDE + ch * 8) = kv;
        LAS bf16* vd = Vt + (ch * 8) * VT_STRIDE + row;
        vd[0 * VT_STRIDE] = (bf16)(vv.x & 0xffffu); vd[1 * VT_STRIDE] = (bf16)(vv.x >> 16);
        vd[2 * VT_STRIDE] = (bf16)(vv.y & 0xffffu); vd[3 * VT_STRIDE] = (bf16)(vv.y >> 16);
        vd[4 * VT_STRIDE] = (bf16)(vv.z & 0xffffu); vd[5 * VT_STRIDE] = (bf16)(vv.z >> 16);
        vd[6 * VT_STRIDE] = (bf16)(vv.w & 0xffffu); vd[7 * VT_STRIDE] = (bf16)(vv.w >> 16);
    }
    __syncthreads();
    const int g = F.wave >> 1, head = hk * 4 + g;
    const float sink2 = sinks[head] * LOG2E;
    for (int qq = 0; qq < 2; ++qq) {
        const int qt = 2 * (F.wave & 1) + qq, i0 = 32 * qt;
        const size_t qrow = (size_t)b * SEQ + nb * 128 + i0 + r;
        bf16x8 qf[4];
#pragma unroll
        for (int ks = 0; ks < 4; ++ks) qf[ks] = *(const bf16x8*)(PROJ + qrow * INW + C_Q + head * 64 + 16 * ks + 8 * h);
        f32x16 s[5];
#pragma unroll
        for (int kt = 0; kt < 5; ++kt) {
            f32x16 a = {};
#pragma unroll
            for (int ks = 0; ks < 4; ++ks) { const bf16x8 kf = *(const LAS bf16x8*)(Ks + (32 * (qt + kt) + r) * KS_STRIDE + 16 * ks + 8 * h); a = MFMA32(kf, qf[ks], a); }
            s[kt] = a;
        }
        const int iq = i0 + r; float mx = -1e30f;
#pragma unroll
        for (int kt = 0; kt < 5; ++kt)
#pragma unroll
            for (int i = 0; i < 16; ++i) { const int j = 32 * (qt + kt) + crow(i, h);
                const bool valid = (j > iq) && (j <= iq + 128) && (nb > 0 || j >= 128);
                const float v = valid ? s[kt][i] * (0.125f * LOG2E) : -1e30f; s[kt][i] = v; mx = fmaxf(mx, v); }
        mx = fmaxf(mx, lane_xor(mx, lane, 32)); mx = fmaxf(mx, sink2);
        float sum = 0.f;
#pragma unroll
        for (int kt = 0; kt < 5; ++kt)
#pragma unroll
            for (int i = 0; i < 16; ++i) { const float p = __builtin_amdgcn_exp2f(s[kt][i] - mx); s[kt][i] = p; sum += p; }
        sum += lane_xor(sum, lane, 32); sum += __builtin_amdgcn_exp2f(sink2 - mx);
        const float inv = 1.0f / sum;
        f32x16 o[2] = {{}, {}};
#pragma unroll
        for (int kt = 0; kt < 5; ++kt)
#pragma unroll
            for (int st = 0; st < 2; ++st) {
                v4u pw; pw.x = pk2(s[kt][8 * st + 0], s[kt][8 * st + 1]); pw.y = pk2(s[kt][8 * st + 2], s[kt][8 * st + 3]);
                pw.z = pk2(s[kt][8 * st + 4], s[kt][8 * st + 5]); pw.w = pk2(s[kt][8 * st + 6], s[kt][8 * st + 7]);
                const bf16x8 pb = __builtin_bit_cast(bf16x8, pw);
#pragma unroll
                for (int db = 0; db < 2; ++db) {
                    const LAS bf16* vp = Vt + (32 * db + r) * VT_STRIDE + 32 * (qt + kt) + 16 * st + 4 * h;
                    const s16x4 lo = *(const LAS s16x4*)vp, hi = *(const LAS s16x4*)(vp + 8);
                    const bf16x8 va = __builtin_shufflevector(lo, hi, 0, 1, 2, 3, 4, 5, 6, 7);
                    o[db] = MFMA32(va, pb, o[db]);
                }
            }
        bf16* orow = MIX + qrow * D + 512 + head * 64;
#pragma unroll
        for (int db = 0; db < 2; ++db)
#pragma unroll
            for (int g4 = 0; g4 < 4; ++g4) { v2u w; w.x = pk2(o[db][4 * g4] * inv, o[db][4 * g4 + 1] * inv); w.y = pk2(o[db][4 * g4 + 2] * inv, o[db][4 * g4 + 3] * inv);
                *(v2u*)(orow + 32 * db + 8 * g4 + 4 * h) = w; }
    }
    __syncthreads();
}

constexpr int DL_STRIDE = 264;
__device__ __forceinline__ void pc_unit(Frame& F, int tok0, int l, const bf16* PROJ, bf16* MIX) {
    LAS bf16* Dl = (LAS bf16*)F.lds;
    const int s0 = tok0 % SEQ;
    const float* cw = F.in[5] + (size_t)l * 3 * 256;
#pragma unroll 1
    for (int i = 0; i < 4; ++i) {
        const int idx = F.tid + 512 * i, tk = idx >> 5, ch = idx & 31, grp = ch >> 3, w = 2 << grp;
        const int s = s0 + tk; const size_t row = (size_t)tok0 + tk;
        float u[8], acc[8]; ld8(PROJ + row * INW + ch * 8, u);
#pragma unroll
        for (int e = 0; e < 8; ++e) acc[e] = u[e];
        const int n = (s + 1 < w) ? s + 1 : w;
        for (int k = 1; k < n; ++k) { float t[8]; ld8(PROJ + (row - k) * INW + ch * 8, t);
#pragma unroll
            for (int e = 0; e < 8; ++e) acc[e] += t[e]; }
        const float rn = 1.0f / (float)n;
        v4u dw; dw.x = pk2(acc[0] * rn - u[0], acc[1] * rn - u[1]); dw.y = pk2(acc[2] * rn - u[2], acc[3] * rn - u[3]);
        dw.z = pk2(acc[4] * rn - u[4], acc[5] * rn - u[5]); dw.w = pk2(acc[6] * rn - u[6], acc[7] * rn - u[7]);
        *(LAS v4u*)(Dl + tk * DL_STRIDE + ch * 8) = dw;
        float y[8];
#pragma unroll
        for (int e = 0; e < 8; ++e) y[e] = 0.f;
#pragma unroll
        for (int j = 0; j < 3; ++j) {
            if (s - 2 + j >= 0) { float gc[8], uc[8]; const bf16* p = PROJ + (row - 2 + j) * INW + ch * 8; ld8(p + C_GC, gc); ld8(p + C_UC, uc);
                const f32x4 wa = *(const f32x4*)(cw + j * 256 + ch * 8), wb = *(const f32x4*)(cw + j * 256 + ch * 8 + 4);
#pragma unroll
                for (int e = 0; e < 4; ++e) { y[e] += wa[e] * gc[e] * uc[e]; y[4 + e] += wb[e] * gc[4 + e] * uc[4 + e]; } }
        }
        float gb[8]; ld8(PROJ + row * INW + C_GB + ch * 8, gb);
        v4u ow; ow.x = pk2(gb[0] * y[0], gb[1] * y[1]); ow.y = pk2(gb[2] * y[2], gb[3] * y[3]); ow.z = pk2(gb[4] * y[4], gb[5] * y[5]); ow.w = pk2(gb[6] * y[6], gb[7] * y[7]);
        *(v4u*)(MIX + row * D + 256 + ch * 8) = ow;
    }
    __syncthreads();
    {
        const int lane = F.lane, r = lane & 31, h = lane >> 5, tt = F.wave & 1, grp = F.wave >> 1;
        const bf16* PT = (const bf16*)(F.ws + WS_POOLT) + (size_t)(l * 4 + grp) * 4096;
        const float* psc = F.in[4] + (size_t)l * 256 + grp * 64;
        bf16x8 df[4];
#pragma unroll
        for (int ks = 0; ks < 4; ++ks) df[ks] = *(const LAS bf16x8*)(Dl + (32 * tt + r) * DL_STRIDE + 64 * grp + 16 * ks + 8 * h);
#pragma unroll
        for (int db = 0; db < 2; ++db) {
            f32x16 a = {};
#pragma unroll
            for (int ks = 0; ks < 4; ++ks) { const bf16x8 wf = *(const bf16x8*)(PT + (32 * db + r) * 64 + 16 * ks + 8 * h); a = MFMA32(wf, df[ks], a); }
            bf16* orow = MIX + ((size_t)tok0 + 32 * tt + r) * D + grp * 64 + 32 * db;
#pragma unroll
            for (int g4 = 0; g4 < 4; ++g4) { const f32x4 sc = *(const f32x4*)(psc + 32 * db + 8 * g4 + 4 * h);
                v2u w; w.x = pk2(a[4 * g4] * sc[0], a[4 * g4 + 1] * sc[1]); w.y = pk2(a[4 * g4 + 2] * sc[2], a[4 * g4 + 3] * sc[3]);
                *(v2u*)(orow + 8 * g4 + 4 * h) = w; }
        }
    }
    __syncthreads();
}

__device__ __forceinline__ void mixer_phase(Frame& F, int l) {
    const bf16* PROJ = (const bf16*)(F.ws + WS_PROJ); bf16* MIX = (bf16*)(F.ws + WS_MIX);
    const float* sinks = F.in[6] + l * 8;
    for (int u = F.bx; u < BATCH * 32 * 2; u += F.G) { const int hk = u & 1, nb = (u >> 1) & 31, b = u >> 6; attn_unit(F, b, nb, hk, PROJ, MIX, sinks); }
    for (int u = F.bx; u < M / 64; u += F.G) pc_unit(F, u * 64, l, PROJ, MIX);
}

__device__ __forceinline__ void fixup_phase(Frame& F, int l) {
    const float* head = (const float*)(F.ws + WS_HEAD); const float* tail = (const float*)(F.ws + WS_TAIL);
    const float* cw = F.in[11] + (size_t)l * 3 * UPW; const float* cb = F.in[12] + (size_t)l * UPW;
    bf16* H = (bf16*)(F.ws + WS_H);
    const int nth = F.G * NWAVES * 64;
    for (int idx = F.bx * (NWAVES * 64) + F.tid; idx < 128 * 2 * (FF / 4); idx += nth) {
        const int pm = idx / (2 * (FF / 4)), rem = idx % (2 * (FF / 4)), r = rem / (FF / 4), f = 4 * (rem % (FF / 4));
        if ((pm & 15) == 0) continue;
        f32x4 y[2];
#pragma unroll
        for (int hf = 0; hf < 2; ++hf) { const int c = hf * FF + f;
            const f32x4 cur = *(const f32x4*)(head + ((size_t)pm * 2 + r) * UPW + c);
            const f32x4 t0 = *(const f32x4*)(tail + ((size_t)(pm - 1) * 2 + 0) * UPW + c), t1 = *(const f32x4*)(tail + ((size_t)(pm - 1) * 2 + 1) * UPW + c);
            const f32x4 h0 = *(const f32x4*)(head + ((size_t)pm * 2 + 0) * UPW + c);
            const f32x4 p1 = r == 0 ? t1 : h0, p2 = r == 0 ? t0 : t1;
            const f32x4 w0 = *(const f32x4*)(cw + c), w1 = *(const f32x4*)(cw + UPW + c), w2 = *(const f32x4*)(cw + 2 * UPW + c), bb = *(const f32x4*)(cb + c);
            y[hf] = w2 * cur + w1 * p1 + w0 * p2 + bb; }
        float hv[4];
#pragma unroll
        for (int j = 0; j < 4; ++j) { const float g = y[0][j]; hv[j] = g * __builtin_amdgcn_rcpf(1.0f + __builtin_amdgcn_exp2f(-LOG2E * g)) * y[1][j]; }
        v2u w; w.x = pk2(hv[0], hv[1]); w.y = pk2(hv[2], hv[3]);
        *(v2u*)(H + ((size_t)pm * 256 + r) * FF + f) = w;
    }
}

#ifndef MK_MULTI
#define MK_MULTI 0
#endif
constexpr int N_PHASES = 1 + 8 * DEPTH;
struct Args { const float* in[15]; float* out; unsigned char* ws; int ph_lo, ph_hi; };
__global__ void __launch_bounds__(NWAVES * 64, 2) mk_fwd(Args args) {
    extern __shared__ __attribute__((aligned(16))) unsigned char lds[];
    cg::grid_group grid = cg::this_grid();
    int tid_c = threadIdx.x; unsigned char* ws_c = args.ws;
    volatile LAS unsigned* MISC = (volatile LAS unsigned*)((LAS unsigned char*)lds + MISC_OFF);
    if (threadIdx.x < 32) MISC[threadIdx.x] = 0u;
    __syncthreads();
    XcdBarrier bar; bar.bar = (unsigned*)(args.ws + WS_CTL); bar.x = 0; bar.st = nullptr;
    if (args.ph_hi - args.ph_lo > 1) bar = xcd_barrier_post((unsigned*)(args.ws + WS_CTL), MISC);
    for (int ph = args.ph_lo; ph < args.ph_hi; ++ph) {
        Frame F;
        asm volatile("" : "+v"(tid_c)); F.tid = tid_c;
        asm volatile("" : "+s"(ws_c)); F.ws = ws_c;
        F.lds = (LAS unsigned char*)lds;
        F.lane = F.tid & 63; F.wave = __builtin_amdgcn_readfirstlane(F.tid >> 6);
        F.G = gridDim.x; F.bx = blockIdx.x;
#pragma unroll
        for (int i = 0; i < 15; ++i) F.in[i] = args.in[i];
        F.out = args.out;
        bf16* XN = (bf16*)(F.ws + WS_XN); bf16* PROJ = (bf16*)(F.ws + WS_PROJ); bf16* MIX = (bf16*)(F.ws + WS_MIX); bf16* HB = (bf16*)(F.ws + WS_H); bf16* Y = (bf16*)(F.ws + WS_Y);
        if (ph == 0) { p0_prologue(F); }
        else {
            const int l = (ph - 1) >> 3, k = (ph - 1) & 7;
            unsigned char* wl = F.ws + WS_W + (size_t)l * W_LAYER;
            if (k == 0 || k == 2 || k == 6) {
                pg8::Gemm g; pg8::EpiBf16 E;
                if (k == 0) { g = pg8::Gemm{XN, (const bf16*)(wl + W_IN), M, INW, D}; E = pg8::EpiBf16{PROJ, INW, (const float*)(F.ws + WS_RSTD)}; }
                else if (k == 2) { g = pg8::Gemm{MIX, (const bf16*)(wl + W_O), M, D, D}; E = pg8::EpiBf16{Y, D}; }
                else { g = pg8::Gemm{HB, (const bf16*)(wl + W_DN), M, D, FF}; E = pg8::EpiBf16{Y, D, nullptr}; }
                pg8::StaticOrder S; S.init(M, g.N, F.G, F.bx);
                pg8::gemm_phase<pg8::EpiBf16, pg8::StaticOrder, true, true>(F.lds, g, S, E, F.tid);
            } else if (k == 1) {
                mixer_phase(F, l);
            } else if (k == 3 || k == 7) {
                const float* gain = (k == 3 ? F.in[8] : F.in[14]) + (size_t)l * D;
                post_rows(F, Y, XN, gain, (float*)(F.ws + WS_RSTD), (k == 7 && l == DEPTH - 1) ? F.out : (float*)nullptr);
            } else if (k == 4) {
                pg8::Gemm g{XN, (const bf16*)(wl + W_UP), M, UPW, D};
                pg8::EpiUpConv E{HB, F.in[11] + (size_t)l * 3 * UPW, F.in[12] + (size_t)l * UPW, (float*)(F.ws + WS_HEAD), (float*)(F.ws + WS_TAIL), (PG8_LAS float*)(F.lds + BND_OFF), (const float*)(F.ws + WS_RSTD)};
                pg8::StaticOrder S; S.init(M, UPW, F.G, F.bx);
                pg8::gemm_phase<pg8::EpiUpConv, pg8::StaticOrder, true, true>(F.lds, g, S, E, F.tid);
            } else {
                fixup_phase(F, l);
            }
        }
        if (ph + 1 < args.ph_hi) { if (args.ph_hi > 100000) grid.sync(); else xcd_barrier(bar); }
    }
}

extern "C" void kernel_launch(void* const* d_in, const int* in_sizes, int n_in, void* d_out, int out_size, void* d_ws, size_t ws_size, hipStream_t stream) {
    static int grid = 0;
    if (grid == 0) {
        if (n_in != 15 || out_size != M * D || ws_size < WS_END) { fprintf(stderr, "kernel_launch: unexpected problem (n_in %d, out %d, ws %zu); nothing launched\n", n_in, out_size, ws_size); grid = -1; return; }
        int dev = 0, cus = 0, per_cu = 0;
        if (hipGetDevice(&dev) != hipSuccess || hipDeviceGetAttribute(&cus, hipDeviceAttributeMultiprocessorCount, dev) != hipSuccess) { grid = -1; return; }
        if (hipFuncSetAttribute((const void*)mk_fwd, hipFuncAttributeMaxDynamicSharedMemorySize, LDS_BYTES) != hipSuccess) { fprintf(stderr, "kernel_launch: hipFuncSetAttribute failed\n"); grid = -1; return; }
        if (hipOccupancyMaxActiveBlocksPerMultiprocessor(&per_cu, (const void*)mk_fwd, NWAVES * 64, LDS_BYTES) != hipSuccess || per_cu < 1) { fprintf(stderr, "kernel_launch: occupancy query says %d\n", per_cu); per_cu = 1; }
        (void)hipGetLastError();
        grid = cus * per_cu;
    }
    if (grid < 0) return;
    if (hipMemsetAsync((char*)d_ws + WS_CTL, 0, CTL_ZERO_BYTES, stream) != hipSuccess) { fprintf(stderr, "kernel_launch: memset failed\n"); return; }
    Args a{};
    for (int i = 0; i < 15; ++i) a.in[i] = (const float*)d_in[i];
    a.out = (float*)d_out; a.ws = (unsigned char*)d_ws;
#if MK_MULTI
    for (int ph = 0; ph < N_PHASES; ++ph) { a.ph_lo = ph; a.ph_hi = ph + 1; hipLaunchKernelGGL(mk_fwd, dim3(grid), dim3(NWAVES * 64), LDS_BYTES, stream, a); }
#else
    a.ph_lo = 0; a.ph_hi = N_PHASES;
    void* kargs[] = {&a};
    hipError_t e = hipLaunchCooperativeKernel((const void*)mk_fwd, dim3(grid), dim3(NWAVES * 64), kargs, LDS_BYTES, stream);
    if (e != hipSuccess) fprintf(stderr, "kernel_launch: cooperative launch failed: %s (grid %d)\n", hipGetErrorString(e), grid);
#endif
}
```

```cpp
#include <hip/hip_runtime.h>
#include <hip/hip_cooperative_groups.h>
#include <cstdio>
#include <cstdint>
namespace cg = cooperative_groups;
namespace pg8 {
#define PG8_LAS __attribute__((address_space(3)))
typedef unsigned short bf16_t;
typedef short bf16x8 __attribute__((ext_vector_type(8)));
typedef float f32x4 __attribute__((ext_vector_type(4)));
typedef unsigned u32x4 __attribute__((ext_vector_type(4)));
constexpr int BM = 256, BK = 64, HALF = 128, HTB = HALF * BK * 2  , STAGE_BYTES = 8 * HTB, NXCD = 8, WGM = 8;

__host__ __device__ __forceinline__ int lds_byte(int r, int c) { const int st = (r >> 4) * 2 + (c >> 5), rr = r & 15, cc = c & 31, ob = rr * 64 + cc * 2; return st * 1024 + (ob ^ (((ob >> 9) & 1) << 5)); }
__host__ __device__ __forceinline__ void stage_rc(int b, int& R, int& C) { const int st = b / 1024, sb = b % 1024, swz = sb ^ (((sb >> 9) & 1) << 5); R = (st >> 1) * 16 + swz / 64; C = (st & 1) * 32 + (swz % 64) / 2; }
__host__ __device__ __forceinline__ int perm32(int rho) { const int n = rho >> 4, i = rho & 15; return 8 * (i >> 2) + 4 * n + (i & 3); }

struct Unit { int pm, pn; };
struct Gemm { const bf16_t* A; const bf16_t* Bt; int M, N, K; };

struct StaticOrder {
    int nM, nN, nwg, G, c;
    __host__ __device__ void init(int M, int N, int G_, int c_) { nM = M / BM; nN = N / BM; nwg = nM * nN; G = G_; c = c_; }
    __host__ __device__ bool next(int i, Unit& u) const {
        const long L = (long)i * G + c; if (L >= nwg) return false;
        int wgid = (int)L; { const int q = nwg / NXCD, r = nwg % NXCD, xcd = wgid % NXCD, off = wgid / NXCD; wgid = (xcd < r ? xcd * (q + 1) : r * (q + 1) + (xcd - r) * q) + off; }
        const int nig = WGM * nN, gid = wgid / nig, fm = gid * WGM, gsz = (nM - fm) < WGM ? (nM - fm) : WGM;
        u.pm = fm + ((wgid % nig) % gsz); u.pn = (wgid % nig) / gsz; return true;
    }
    __device__ __forceinline__ void a_ready(const Unit&) const {}
    __device__ __forceinline__ void done(const Unit&) const {}
};

__device__ __forceinline__ unsigned cvt_pk_bf16(float lo, float hi) { unsigned r; asm volatile("v_cvt_pk_bf16_f32 %0, %1, %2" : "=v"(r) : "v"(lo), "v"(hi)); return r; }
typedef float f32x2 __attribute__((ext_vector_type(2)));
typedef unsigned u32x2 __attribute__((ext_vector_type(2)));
struct EpiBf16 {
    static constexpr bool PERM = true, AFTER_DRAIN = false;
    bf16_t* O; int ldc; const float* rs;
    __device__ __forceinline__ void operator()(f32x4 (&acc)[2][2][4][2], const Unit& u, int wr, int wc, int fr, int fq) const {
        const int row0 = u.pm * BM + wr * 64 + fr; const int col0 = u.pn * BM + wc * 32 + 8 * fq;
#pragma unroll
        for (int ai = 0; ai < 2; ++ai)
#pragma unroll
            for (int m = 0; m < 4; ++m) { bf16_t* rowp = O + (size_t)(row0 + ai * HALF + m * 16) * ldc + col0;
                const float sc = rs ? rs[row0 + ai * HALF + m * 16] : 1.0f;
#pragma unroll
                for (int bj = 0; bj < 2; ++bj) { const f32x4 v0 = acc[ai][bj][m][0] * sc, v1 = acc[ai][bj][m][1] * sc;
                    u32x4 w; w.x = cvt_pk_bf16(v0[0], v0[1]); w.y = cvt_pk_bf16(v0[2], v0[3]); w.z = cvt_pk_bf16(v1[0], v1[1]); w.w = cvt_pk_bf16(v1[2], v1[3]);
                    *(u32x4*)(rowp + bj * HALF) = w; } }
    }
};

#ifndef ROT_DPP
#define ROT_DPP 0
#endif
__device__ __forceinline__ float rot_lane1(float v) { return __builtin_bit_cast(float, __builtin_amdgcn_update_dpp(0, __builtin_bit_cast(int, v), 0x121, 0xf, 0xf, false)); }
__device__ __forceinline__ float rot_lane2(float v) { return __builtin_bit_cast(float, __builtin_amdgcn_update_dpp(0, __builtin_bit_cast(int, v), 0x122, 0xf, 0xf, false)); }
struct EpiUpConv {
    static constexpr bool PERM = true, AFTER_DRAIN = false;
    static constexpr int FF = 2816, UPW = 5632;
    bf16_t* H; const float* cw; const float* cb; float* head; float* tail; PG8_LAS float* bnd; const float* rs;
    __device__ __forceinline__ void operator()(f32x4 (&acc)[2][2][4][2], const Unit& u, int wr, int wc, int fr, int fq) const {
#pragma unroll
        for (int ai = 0; ai < 2; ++ai)
#pragma unroll
            for (int m = 0; m < 4; ++m) { const float sc = rs[u.pm * BM + ai * HALF + wr * 64 + m * 16 + fr];
#pragma unroll
                for (int bj = 0; bj < 2; ++bj)
#pragma unroll
                    for (int n = 0; n < 2; ++n) acc[ai][bj][m][n] *= sc; }
        const int xcol = wc * 32 + 8 * fq;
        const int fcol = u.pn * 128 + xcol;
        if (fr >= 14) {
#pragma unroll
            for (int ai = 0; ai < 2; ++ai)
#pragma unroll
                for (int bj = 0; bj < 2; ++bj)
#pragma unroll
                    for (int n = 0; n < 2; ++n) *(PG8_LAS f32x4*)(bnd + ((2 * ai + wr) * 2 + (fr - 14)) * 256 + bj * 128 + xcol + 4 * n) = acc[ai][bj][3][n];
        }
        if (wr == 0 && fr < 2) {
#pragma unroll
            for (int bj = 0; bj < 2; ++bj)
#pragma unroll
                for (int n = 0; n < 2; ++n) *(f32x4*)(head + ((size_t)u.pm * 2 + fr) * UPW + bj * FF + fcol + 4 * n) = acc[0][bj][0][n];
        }
        if (wr == 1 && fr >= 14) {
#pragma unroll
            for (int bj = 0; bj < 2; ++bj)
#pragma unroll
                for (int n = 0; n < 2; ++n) *(f32x4*)(tail + ((size_t)u.pm * 2 + (fr - 14)) * UPW + bj * FF + fcol + 4 * n) = acc[1][bj][3][n];
        }
        asm volatile("s_waitcnt lgkmcnt(0)" ::: "memory"); __builtin_amdgcn_s_barrier(); asm volatile("" ::: "memory");
        u32x2 pk0[2][4];
#pragma unroll
        for (int n = 0; n < 2; ++n) {
            f32x4 w0[2], w1[2], w2[2], bb[2];
#pragma unroll
            for (int bj = 0; bj < 2; ++bj) { const int c = bj * FF + fcol + 4 * n;
                w0[bj] = *(const f32x4*)(cw + c); w1[bj] = *(const f32x4*)(cw + UPW + c); w2[bj] = *(const f32x4*)(cw + 2 * UPW + c); bb[bj] = *(const f32x4*)(cb + c); }
#pragma unroll
            for (int ai = 0; ai < 2; ++ai) {
                const int blk = 2 * ai + wr;
                f32x4 y[2][4];
#pragma unroll
                for (int bj = 0; bj < 2; ++bj) {
                    f32x4 pr1 = (f32x4){0.f, 0.f, 0.f, 0.f}, pr2 = (f32x4){0.f, 0.f, 0.f, 0.f};
                    if (blk > 0) {
                        pr1 = *(const PG8_LAS f32x4*)(bnd + ((blk - 1) * 2 + 1) * 256 + bj * 128 + xcol + 4 * n);
                        pr2 = *(const PG8_LAS f32x4*)(bnd + ((blk - 1) * 2 + (fr == 0 ? 0 : 1)) * 256 + bj * 128 + xcol + 4 * n);
                    }
#pragma unroll
                    for (int m = 0; m < 4; ++m) {
                        const f32x4 cur = acc[ai][bj][m][n]; f32x4 r1, r2;
#pragma unroll
                        for (int j = 0; j < 4; ++j) { r1[j] = rot_lane1(cur[j]); r2[j] = rot_lane2(cur[j]); }
                        const f32x4 p1 = fr >= 1 ? r1 : pr1, p2 = fr >= 2 ? r2 : pr2;
                        y[bj][m] = w2[bj] * cur + w1[bj] * p1 + w0[bj] * p2 + bb[bj];
                        pr1 = r1; pr2 = r2;
                    }
                }
#pragma unroll
                for (int m = 0; m < 4; ++m) {
                    f32x4 hv;
#pragma unroll
                    for (int j = 0; j < 4; ++j) { const float g = y[0][m][j]; hv[j] = g * __builtin_amdgcn_rcpf(1.0f + __builtin_amdgcn_exp2f(-1.4426950408889634f * g)) * y[1][m][j]; }
                    if (n == 0) { pk0[ai][m].x = cvt_pk_bf16(hv[0], hv[1]); pk0[ai][m].y = cvt_pk_bf16(hv[2], hv[3]); }
                    else { u32x4 w; w.x = pk0[ai][m].x; w.y = pk0[ai][m].y; w.z = cvt_pk_bf16(hv[0], hv[1]); w.w = cvt_pk_bf16(hv[2], hv[3]);
                        const int row = u.pm * BM + ai * HALF + wr * 64 + m * 16 + fr;
                        *(u32x4*)(H + (size_t)row * FF + fcol) = w; }
                }
            }
        }
    }
};

template <class Epi, class Sched, bool ALIGN_EPI = false, bool SP2 = false>
__device__ __forceinline__ void gemm_phase(PG8_LAS unsigned char* lds, const Gemm g, const Sched& S, const Epi& E, const int tid) {
    const int wid = __builtin_amdgcn_readfirstlane(tid >> 6), lane = tid & 63, wr = wid >> 2, wc = wid & 3, fr = lane & 15, fq = lane >> 4;
    const int K = g.K, nt = K / BK;
    unsigned voffA[2], voffB[2];
#pragma unroll
    for (int i = 0; i < 2; ++i) { int R, C; stage_rc(tid * 16 + i * 8192, R, C); const int Rb = Epi::PERM ? ((R & ~31) + perm32(R & 31)) : R;
        voffA[i] = (unsigned)(R * K + C) * 2u; voffB[i] = (unsigned)(Rb * K + C) * 2u; }
    const size_t kstep = (size_t)(BK * 2);
    const size_t hstep = (size_t)HALF * K * 2;
    const size_t tstep = 2 * hstep;
    const unsigned ldsw = (unsigned)wid * 1024u;
    const int aoff = lds_byte(wr * 64 + fr, fq * 8), boff = lds_byte(wc * 32 + fr, fq * 8);
#define PG8_SA(b, h) (((b) * 2 + (h)) * HTB)
#define PG8_SB(b, h) ((4 + (b) * 2 + (h)) * HTB)
#define PG8_STAGE(bufoff, gbase, voff) do { _Pragma("unroll") for (int _i = 0; _i < 2; ++_i) \
        __builtin_amdgcn_global_load_lds((const unsigned*)((const char*)(gbase) + (voff)[_i]), (PG8_LAS unsigned*)(lds + (bufoff) + ldsw + _i * 8192), 16, 0, 0); } while (0)
#define PG8_LDA(dst, b, h) do { _Pragma("unroll") for (int m = 0; m < 4; ++m) _Pragma("unroll") for (int k = 0; k < 2; ++k) dst[m][k] = *(const PG8_LAS bf16x8*)(lds + PG8_SA(b, h) + aoff + m * 2048 + k * 1024); } while (0)
#define PG8_LDB(dst, b, h) do { _Pragma("unroll") for (int n = 0; n < 2; ++n) _Pragma("unroll") for (int k = 0; k < 2; ++k) dst[n][k] = *(const PG8_LAS bf16x8*)(lds + PG8_SB(b, h) + boff + n * 2048 + k * 1024); } while (0)
#define PG8_MMA(ai, bj, At, Bt) do { __builtin_amdgcn_s_setprio(1); _Pragma("unroll") for (int m = 0; m < 4; ++m) _Pragma("unroll") for (int n = 0; n < 2; ++n) _Pragma("unroll") for (int k = 0; k < 2; ++k) \
        acc[ai][bj][m][n] = __builtin_amdgcn_mfma_f32_16x16x32_bf16(Bt[n][k], At[m][k], acc[ai][bj][m][n], 0, 0, 0); __builtin_amdgcn_s_setprio(0); } while (0)
#define PG8_WAIT_V(n) asm volatile("s_waitcnt vmcnt(" #n ")" ::: "memory")
#define PG8_WAIT_L(n) asm volatile("s_waitcnt lgkmcnt(" #n ")" ::: "memory")
#define PG8_BAR __builtin_amdgcn_s_barrier()
#define PG8_SCHED __builtin_amdgcn_sched_barrier(0)
    Unit cur, nxt; int ui = 0;
    if (!S.next(0, cur)) return;
    f32x4 acc[2][2][4][2];
#pragma unroll
    for (int a = 0; a < 2; ++a)
#pragma unroll
        for (int b = 0; b < 2; ++b)
#pragma unroll
            for (int m = 0; m < 4; ++m)
#pragma unroll
                for (int n = 0; n < 2; ++n) acc[a][b][m][n] = (f32x4){0.f, 0.f, 0.f, 0.f};
    bf16x8 At[4][2], B0[2][2], B1[2][2];
    const char* cA = (const char*)g.A + (size_t)cur.pm * tstep; const char* cB = (const char*)g.Bt + (size_t)cur.pn * tstep;
    S.a_ready(cur);
    if constexpr (SP2) {
        PG8_STAGE(PG8_SB(0, 0), cB, voffB); PG8_STAGE(PG8_SB(0, 1), cB + hstep, voffB); PG8_STAGE(PG8_SA(0, 0), cA, voffA); PG8_STAGE(PG8_SA(0, 1), cA + hstep, voffA);
        if (wr == 1) PG8_BAR;
        PG8_WAIT_V(2); PG8_BAR;
        PG8_STAGE(PG8_SB(1, 0), cB + kstep, voffB); PG8_STAGE(PG8_SA(1, 0), cA + kstep, voffA); PG8_STAGE(PG8_SB(1, 1), cB + hstep + kstep, voffB);
        PG8_WAIT_V(6); PG8_BAR;
    } else {
        PG8_STAGE(PG8_SB(0, 0), cB, voffB); PG8_STAGE(PG8_SA(0, 0), cA, voffA); PG8_STAGE(PG8_SB(0, 1), cB + hstep, voffB); PG8_STAGE(PG8_SA(0, 1), cA + hstep, voffA);
        if (wr == 1) PG8_BAR;
        PG8_WAIT_V(4); PG8_BAR;
        PG8_STAGE(PG8_SB(1, 0), cB + kstep, voffB); PG8_STAGE(PG8_SA(1, 0), cA + kstep, voffA); PG8_STAGE(PG8_SB(1, 1), cB + hstep + kstep, voffB);
        PG8_WAIT_V(6); PG8_BAR;
    }
    for (;;) {
        const bool has_next = S.next(ui + 1, nxt);
        const char* nA = has_next ? (const char*)g.A + (size_t)nxt.pm * tstep : cA; const char* nB = has_next ? (const char*)g.Bt + (size_t)nxt.pn * tstep : cB;
        for (int t = 0; t < nt; t += 2) {
            const bool last = (t == nt - 2);
            const char* a1 = cA + (size_t)(t + 1) * kstep;
            const char* a2 = last ? nA : cA + (size_t)(t + 2) * kstep; const char* b2 = last ? nB : cB + (size_t)(t + 2) * kstep;
            const char* a3 = a2 + kstep; const char* b3 = b2 + kstep;
            if (last && has_next) S.a_ready(nxt);
            if constexpr (SP2) {
            PG8_LDB(B0, 0, 0); PG8_LDB(B1, 0, 1); PG8_SCHED; PG8_LDA(At, 0, 0); PG8_STAGE(PG8_SA(1, 1), a1 + hstep, voffA);
            PG8_WAIT_V(8); PG8_WAIT_L(0); PG8_BAR; PG8_MMA(0, 0, At, B0); PG8_MMA(0, 1, At, B1); PG8_BAR; PG8_SCHED;
            PG8_LDA(At, 0, 1); PG8_STAGE(PG8_SB(0, 0), b2, voffB); PG8_STAGE(PG8_SB(0, 1), b2 + hstep, voffB); PG8_STAGE(PG8_SA(0, 0), a2, voffA);
            PG8_WAIT_V(8); PG8_WAIT_L(0); PG8_BAR; PG8_MMA(1, 0, At, B0); PG8_MMA(1, 1, At, B1); PG8_BAR; PG8_SCHED;
            PG8_LDB(B0, 1, 0); PG8_LDB(B1, 1, 1); PG8_SCHED; PG8_LDA(At, 1, 0); PG8_STAGE(PG8_SA(0, 1), a2 + hstep, voffA);
            PG8_WAIT_V(8); PG8_WAIT_L(0); PG8_BAR; PG8_MMA(0, 0, At, B0); PG8_MMA(0, 1, At, B1); PG8_BAR; PG8_SCHED;
            PG8_LDA(At, 1, 1); PG8_STAGE(PG8_SB(1, 0), b3, voffB); PG8_STAGE(PG8_SB(1, 1), b3 + hstep, voffB); PG8_STAGE(PG8_SA(1, 0), a3, voffA);
            PG8_WAIT_V(8); PG8_WAIT_L(0); PG8_BAR; PG8_MMA(1, 0, At, B0); PG8_MMA(1, 1, At, B1); PG8_BAR; PG8_SCHED;
            } else {
            PG8_LDB(B0, 0, 0); PG8_SCHED; PG8_LDA(At, 0, 0); PG8_STAGE(PG8_SA(1, 1), a1 + hstep, voffA);
            PG8_WAIT_L(8); PG8_BAR; PG8_WAIT_L(0); PG8_MMA(0, 0, At, B0); PG8_BAR; PG8_SCHED;
            PG8_LDB(B1, 0, 1); PG8_STAGE(PG8_SB(0, 0), b2, voffB);
            PG8_BAR; PG8_WAIT_L(0); PG8_MMA(0, 1, At, B1); PG8_BAR;
            PG8_LDA(At, 0, 1); PG8_STAGE(PG8_SA(0, 0), a2, voffA);
            PG8_BAR; PG8_WAIT_L(0); PG8_MMA(1, 0, At, B0); PG8_BAR; PG8_SCHED;
            PG8_STAGE(PG8_SB(0, 1), b2 + hstep, voffB);
            PG8_WAIT_V(6); PG8_BAR; PG8_MMA(1, 1, At, B1); PG8_BAR;
            PG8_LDB(B0, 1, 0); PG8_SCHED; PG8_LDA(At, 1, 0); PG8_STAGE(PG8_SA(0, 1), a2 + hstep, voffA);
            PG8_WAIT_L(8); PG8_BAR; PG8_WAIT_L(0); PG8_MMA(0, 0, At, B0); PG8_BAR; PG8_SCHED;
            PG8_LDB(B1, 1, 1); PG8_STAGE(PG8_SB(1, 0), b3, voffB);
            PG8_BAR; PG8_WAIT_L(0); PG8_MMA(0, 1, At, B1); PG8_BAR;
            PG8_LDA(At, 1, 1); PG8_STAGE(PG8_SA(1, 0), a3, voffA);
            PG8_BAR; PG8_WAIT_L(0); PG8_MMA(1, 0, At, B0); PG8_BAR; PG8_SCHED;
            PG8_STAGE(PG8_SB(1, 1), b3 + hstep, voffB);
            PG8_WAIT_V(6); PG8_BAR; PG8_MMA(1, 1, At, B1); PG8_BAR;
            }
        }
        if constexpr (ALIGN_EPI) { if (wr == 0) PG8_BAR; }
        if constexpr (!Epi::AFTER_DRAIN) { E(acc, cur, wr, wc, fr, fq); S.done(cur); }
        if (!has_next) break;
#pragma unroll
        for (int a = 0; a < 2; ++a)
#pragma unroll
            for (int b = 0; b < 2; ++b)
#pragma unroll
                for (int m = 0; m < 4; ++m)
#pragma unroll
                    for (int n = 0; n < 2; ++n) acc[a][b][m][n] = (f32x4){0.f, 0.f, 0.f, 0.f};
        cur = nxt; cA = nA; cB = nB; ++ui;
        if constexpr (ALIGN_EPI) { if (wr == 1) PG8_BAR; }
    }
    PG8_WAIT_V(0);
    if constexpr (!ALIGN_EPI) { if (wr == 0) PG8_BAR; }
    PG8_BAR;
    if constexpr (Epi::AFTER_DRAIN) { E.fused(acc, cur, wr, wc, fr, fq, lds, wid, lane); S.done(cur); }
#undef PG8_SA
#undef PG8_SB
#undef PG8_STAGE
#undef PG8_LDA
#undef PG8_LDB
#undef PG8_MMA
#undef PG8_WAIT_V
#undef PG8_WAIT_L
#undef PG8_BAR
#undef PG8_SCHED
}
}

constexpr int NWAVES = 8;
constexpr int BATCH = 8, SEQ = 4096, D = 1024, DEPTH = 4, M = BATCH * SEQ;
constexpr int INW = 1792, FF = 2816, UPW = 2 * FF;
constexpr int C_GB = 256, C_GC = 512, C_UC = 768, C_Q = 1024, C_K = 1536, C_V = 1664;
constexpr float EPS = 1e-6f;
constexpr float LOG2E = 1.4426950408889634f;

constexpr size_t MiB = 1u << 20;
constexpr size_t WS_CTL = 0, CTL_ZERO_BYTES = 64 * 1024;
constexpr size_t WS_W = 1 * MiB;
constexpr size_t W_LAYER = 22 * MiB, W_IN = 0, W_O = (size_t)INW * D * 2, W_UP = W_O + (size_t)D * D * 2, W_DN = W_UP + (size_t)UPW * D * 2;
static_assert(W_DN + (size_t)D * FF * 2 <= W_LAYER, "weight layer map");
constexpr size_t WS_POOLT = 89 * MiB;
constexpr size_t WS_XN = 90 * MiB;
constexpr size_t WS_PROJ = 154 * MiB;
constexpr size_t WS_MIX = 266 * MiB;
constexpr size_t WS_H = 154 * MiB;
constexpr size_t WS_Y = 330 * MiB;
constexpr size_t WS_HEAD = 394 * MiB, WS_TAIL = 400 * MiB;
constexpr size_t WS_RSTD = 406 * MiB;
constexpr size_t WS_END = 407 * MiB;
static_assert(WS_PROJ + (size_t)M * INW * 2 <= WS_MIX && WS_H + (size_t)M * FF * 2 <= WS_Y && WS_HEAD + (size_t)128 * 2 * UPW * 4 <= WS_TAIL, "d_ws map");

constexpr int RING_BYTES = 131072, BND_OFF = RING_BYTES, LDS_BYTES = 147456, MISC_OFF = LDS_BYTES - 128;

#define LAS __attribute__((address_space(3)))
typedef unsigned short bf16;
typedef unsigned v4u __attribute__((ext_vector_type(4)));
typedef unsigned v2u __attribute__((ext_vector_type(2)));
typedef float f32x4 __attribute__((ext_vector_type(4)));
typedef float f32x16 __attribute__((ext_vector_type(16)));
typedef short bf16x8 __attribute__((ext_vector_type(8)));
typedef short s16x4 __attribute__((ext_vector_type(4)));
#define LDS_WAIT() asm volatile("s_waitcnt lgkmcnt(0)" ::: "memory")
#define MFMA32(a, b, c) __builtin_amdgcn_mfma_f32_32x32x16_bf16((a), (b), (c), 0, 0, 0)

__device__ __forceinline__ unsigned f2bf(float f) { unsigned u = __builtin_bit_cast(unsigned, f); return (u + 0x7fffu + ((u >> 16) & 1u)) >> 16; }
typedef float f32x2_t __attribute__((ext_vector_type(2))); typedef __bf16 bf16x2_t __attribute__((ext_vector_type(2)));
__device__ __forceinline__ unsigned pk2(float lo, float hi) { f32x2_t v = {lo, hi}; bf16x2_t b = __builtin_convertvector(v, bf16x2_t); return __builtin_bit_cast(unsigned, b); }
__device__ __forceinline__ float bf_lo(unsigned w) { return __builtin_bit_cast(float, w << 16); }
__device__ __forceinline__ float bf_hi(unsigned w) { return __builtin_bit_cast(float, w & 0xffff0000u); }
__device__ __forceinline__ int crow(int r, int hi) { return (r & 3) + 8 * (r >> 2) + 4 * hi; }
__device__ __forceinline__ float lane_xor(float v, int lane, int o) { return __builtin_bit_cast(float, __builtin_amdgcn_ds_bpermute((lane ^ o) << 2, __builtin_bit_cast(int, v))); }
__device__ __forceinline__ float wave_sum(float v, int lane) {
#pragma unroll
    for (int o = 1; o < 64; o <<= 1) v += lane_xor(v, lane, o);
    return v;
}

#define XB_TMO      128
#define XB_XCNT(j)  (256  + 64 * (j))
#define XB_XSUB(j)  (1280 + 64 * (j))
#define XB_XGEN(j)  (2304 + 64 * (j))
#define XB_TOP      3328
#define XB_TOPGEN   3392
#define XCD_BAR_WORDS 3456
#define XB_SPIN_CAP (1u << 18)

__device__ __forceinline__ unsigned xb_ld(unsigned* p)              { return __hip_atomic_load(p, __ATOMIC_RELAXED, __HIP_MEMORY_SCOPE_AGENT); }
__device__ __forceinline__ unsigned xb_add(unsigned* p, unsigned v) { return __hip_atomic_fetch_add(p, v, __ATOMIC_RELAXED, __HIP_MEMORY_SCOPE_AGENT); }
__device__ __forceinline__ unsigned xb_xcc_id() { return (unsigned)__builtin_amdgcn_s_getreg((3 << 11) | 20) & 0xFu; }
#define XB_SPIN(cond, bar) do { unsigned _sp = 0; while (cond) { __builtin_amdgcn_s_sleep(1); \
    if ((++_sp & 255u) == 0u) { if (xb_ld(&(bar)[XB_TMO])) break; if (_sp > XB_SPIN_CAP) { atomicAdd(&(bar)[XB_TMO], 1u); break; } } } } while (0)

struct XcdBarrier {
    unsigned* bar; unsigned x;
    volatile LAS unsigned* st;
};

__device__ __forceinline__ XcdBarrier xcd_barrier_post(unsigned* bar, volatile LAS unsigned* st) {
    XcdBarrier b; b.bar = bar; b.x = xb_xcc_id(); b.st = st;
    if (threadIdx.x == 0) (void)xb_add(&bar[XB_XCNT(b.x)], 1u);
    return b;
}
__device__ __forceinline__ void xcd_barrier_complete(unsigned* bar, unsigned x, unsigned& nloc, unsigned& nx) {
    const unsigned G = gridDim.x * gridDim.y * gridDim.z;
    unsigned sum, cnt, mine, sp = 0u;
    for (;;) {
        sum = 0u; cnt = 0u; mine = 0u;
#pragma unroll
        for (unsigned j = 0; j < 16; ++j) { const unsigned c = xb_ld(&bar[XB_XCNT(j)]); sum += c; cnt += (c > 0u) ? 1u : 0u; mine = (j == x) ? c : mine; }
        if (sum == G) break;
        __builtin_amdgcn_s_sleep(1);
        if ((++sp & 255u) == 0u) { if (xb_ld(&bar[XB_TMO])) break; if (sp > XB_SPIN_CAP) { atomicAdd(&bar[XB_TMO], 1u); break; } }
    }
    nloc = mine > 0u ? mine : 1u; nx = cnt > 0u ? cnt : 1u;
}

__device__ __forceinline__ void xcd_barrier(const XcdBarrier& b) {
    asm volatile("s_waitcnt vmcnt(0)" ::: "memory");
    __syncthreads();
    if (threadIdx.x == 0) {
        unsigned* bar = b.bar;
        __builtin_amdgcn_s_waitcnt(0);
        unsigned nloc = b.st[0], nx = b.st[1];
        if (nloc == 0u) { xcd_barrier_complete(bar, b.x, nloc, nx); b.st[0] = nloc; b.st[1] = nx; }
        const unsigned old = xb_add(&bar[XB_XSUB(b.x)], 1u);
        const unsigned gen = old / nloc;
        if (old + 1u == (gen + 1u) * nloc) {
            __builtin_amdgcn_fence(__ATOMIC_RELEASE, "agent");
            asm volatile("s_waitcnt vmcnt(0)" ::: "memory");
            const unsigned og = xb_add(&bar[XB_TOP], 1u);
            const unsigned tg = og / nx;
            if (og + 1u == (tg + 1u) * nx) xb_add(&bar[XB_TOPGEN], 1u);
            else XB_SPIN(xb_ld(&bar[XB_TOPGEN]) == tg, bar);
            __builtin_amdgcn_fence(__ATOMIC_ACQUIRE, "agent");
            xb_add(&bar[XB_XGEN(b.x)], 1u);
            asm volatile("s_waitcnt vmcnt(0)" ::: "memory");
        } else {
            XB_SPIN(xb_ld(&bar[XB_XGEN(b.x)]) == gen, bar);
            __builtin_amdgcn_fence(__ATOMIC_ACQUIRE, "agent");
            asm volatile("s_waitcnt vmcnt(0)" ::: "memory");
        }
    }
    __syncthreads();
}

struct Frame {
    LAS unsigned char* lds;
    int tid, lane, wave, G, bx;
    const float* in[15]; float* out; unsigned char* ws;
};

__device__ __forceinline__ void p0_item(const float* W, int K, int N, const float* gain, bf16* WT, int mode, LAS float* scr, int item, int lane) {
    const int nblk = N / 32, kb = item / nblk, nb = item % nblk, k0 = 64 * kb, n0 = 32 * nb;
#pragma unroll
    for (int i = 0; i < 32; ++i) { const int kk = 2 * i + (lane >> 5); const float gsc = gain ? gain[k0 + kk] : 1.0f; scr[kk * 33 + (lane & 31)] = W[(size_t)(k0 + kk) * N + n0 + (lane & 31)] * gsc; }
    LDS_WAIT(); asm volatile("" ::: "memory");
    int d0 = n0;
    if (mode == 1) { d0 = (n0 < FF) ? 256 * (n0 / 128) + (n0 % 128) : 256 * ((n0 - FF) / 128) + 128 + ((n0 - FF) % 128); }
    const int c = lane & 7;
#pragma unroll
    for (int j = 0; j < 4; ++j) { const int n = (lane >> 3) + 8 * j; const LAS float* s = scr + (8 * c) * 33 + n;
        v4u o; o.x = pk2(s[0 * 33], s[1 * 33]); o.y = pk2(s[2 * 33], s[3 * 33]); o.z = pk2(s[4 * 33], s[5 * 33]); o.w = pk2(s[6 * 33], s[7 * 33]);
        *(v4u*)(WT + (size_t)(d0 + n) * K + k0 + 8 * c) = o; }
    LDS_WAIT(); asm volatile("" ::: "memory");
}

__device__ __forceinline__ void x_row_to_bf16(int lane, const float* xrow, bf16* orow, float* rstd_out) {
    const f32x4* xr = (const f32x4*)xrow + lane;
    f32x4 v[4]; float s = 0.f;
#pragma unroll
    for (int j = 0; j < 4; ++j) { v[j] = xr[64 * j]; s += (v[j].x * v[j].x + v[j].y * v[j].y) + (v[j].z * v[j].z + v[j].w * v[j].w); }
    const float rstd = 1.0f / sqrtf(wave_sum(s, lane) * (1.f / D) + EPS);
    if (lane == 0) *rstd_out = rstd;
    v2u* o8 = (v2u*)orow + lane;
#pragma unroll
    for (int j = 0; j < 4; ++j) { v2u w; w.x = pk2(v[j].x, v[j].y); w.y = pk2(v[j].z, v[j].w); o8[64 * j] = w; }
}

__device__ __forceinline__ void p0_prologue(Frame& F) {
    LAS float* scr = (LAS float*)(F.lds + F.wave * 16384);
    const int gw = F.bx * NWAVES + F.wave, NGW = F.G * NWAVES;
    constexpr int I_IN = (D / 64) * (INW / 32), I_O = (D / 64) * (D / 32), I_UP = (D / 64) * (UPW / 32), I_DN = (FF / 64) * (D / 32), I_PL = 4 * 2;
    constexpr int I_LAYER = I_IN + I_O + I_UP + I_DN + I_PL;
    for (int it = gw; it < DEPTH * I_LAYER; it += NGW) {
        const int l = it / I_LAYER; int r = it % I_LAYER;
        unsigned char* wl = F.ws + WS_W + (size_t)l * W_LAYER;
        if (r < I_IN) { p0_item(F.in[2] + (size_t)l * D * INW, D, INW, F.in[1] + l * D, (bf16*)(wl + W_IN), 0, scr, r, F.lane); continue; } r -= I_IN;
        if (r < I_O) { p0_item(F.in[7] + (size_t)l * D * D, D, D, nullptr, (bf16*)(wl + W_O), 0, scr, r, F.lane); continue; } r -= I_O;
        if (r < I_UP) { p0_item(F.in[10] + (size_t)l * D * UPW, D, UPW, F.in[9] + l * D, (bf16*)(wl + W_UP), 1, scr, r, F.lane); continue; } r -= I_UP;
        if (r < I_DN) { p0_item(F.in[13] + (size_t)l * FF * D, FF, D, nullptr, (bf16*)(wl + W_DN), 0, scr, r, F.lane); continue; } r -= I_DN;
        { const int g = r >> 1; p0_item(F.in[3] + (size_t)(l * 4 + g) * 4096, 64, 64, nullptr, (bf16*)(F.ws + WS_POOLT) + (size_t)(l * 4 + g) * 4096, 0, scr, r & 1, F.lane); }
    }
    bf16* XN = (bf16*)(F.ws + WS_XN);
    float* RS = (float*)(F.ws + WS_RSTD);
    for (int m = gw; m < M; m += NGW) x_row_to_bf16(F.lane, F.in[0] + (size_t)m * D, XN + (size_t)m * D, RS + m);
}

__device__ __forceinline__ void post_rows(Frame& F, const bf16* Y, bf16* XB, const float* gain, float* RS, float* fout) {
    const int gw = F.bx * NWAVES + F.wave, NGW = F.G * NWAVES;
    f32x4 gv[4];
#pragma unroll
    for (int j = 0; j < 4; ++j) gv[j] = ((const f32x4*)gain)[F.lane + 64 * j];
    for (int m = gw; m < M; m += NGW) {
        const v2u* yr = (const v2u*)(Y + (size_t)m * D) + F.lane;
        v2u* br = (v2u*)(XB + (size_t)m * D) + F.lane;
        f32x4 yv[4], xv[4]; float s = 0.f;
#pragma unroll
        for (int j = 0; j < 4; ++j) { const v2u w = yr[64 * j], b = br[64 * j]; xv[j] = (f32x4){bf_lo(b.x), bf_hi(b.x), bf_lo(b.y), bf_hi(b.y)}; yv[j] = (f32x4){bf_lo(w.x), bf_hi(w.x), bf_lo(w.y), bf_hi(w.y)};
            s += (yv[j].x * yv[j].x + yv[j].y * yv[j].y) + (yv[j].z * yv[j].z + yv[j].w * yv[j].w); }
        const float rstd = 1.0f / sqrtf(wave_sum(s, F.lane) * (1.f / D) + EPS);
        float s2 = 0.f;
#pragma unroll
        for (int j = 0; j < 4; ++j) { xv[j] = xv[j] + yv[j] * rstd * gv[j];
            s2 += (xv[j].x * xv[j].x + xv[j].y * xv[j].y) + (xv[j].z * xv[j].z + xv[j].w * xv[j].w); }
        if (fout) {
            f32x4* orow = (f32x4*)(fout + (size_t)m * D) + F.lane;
#pragma unroll
            for (int j = 0; j < 4; ++j) orow[64 * j] = xv[j];
        } else {
            const float r2 = 1.0f / sqrtf(wave_sum(s2, F.lane) * (1.f / D) + EPS);
            if (F.lane == 0) RS[m] = r2;
#pragma unroll
            for (int j = 0; j < 4; ++j) { v2u w; w.x = pk2(xv[j].x, xv[j].y); w.y = pk2(xv[j].z, xv[j].w); br[64 * j] = w; }
        }
    }
}

__device__ __forceinline__ void ld8(const bf16* p, float (&v)[8]) {
    const v4u w = *(const v4u*)p;
    v[0] = bf_lo(w.x); v[1] = bf_hi(w.x); v[2] = bf_lo(w.y); v[3] = bf_hi(w.y); v[4] = bf_lo(w.z); v[5] = bf_hi(w.z); v[6] = bf_lo(w.w); v[7] = bf_hi(w.w);
}
constexpr int KS_STRIDE = 72, VT_STRIDE = 264, VT_OFF = 256 * KS_STRIDE * 2;
__device__ __forceinline__ void attn_unit(Frame& F, int b, int nb, int hk, const bf16* PROJ, bf16* MIX, const float* sinks) {
    LAS bf16* Ks = (LAS bf16*)F.lds; LAS bf16* Vt = (LAS bf16*)(F.lds + VT_OFF);
    const int lane = F.lane, r = lane & 31, h = lane >> 5;
#pragma unroll
    for (int i = 0; i < 4; ++i) {
        const int idx = F.tid + 512 * i, row = idx >> 3, ch = idx & 7;
        int pos = nb * 128 - 128 + row; if (pos < 0) pos += 128;
        const bf16* src = PROJ + (size_t)(b * SEQ + pos) * INW + hk * 64 + ch * 8;
        const v4u kv = *(const v4u*)(src + C_K), vv = *(const v4u*)(src + C_V);
        *(LAS v4u*)(Ks + row * KS_STRIDE + ch * 8) = kv;
        LAS bf16* vd = Vt + (ch * 8) * VT_STRIDE + row;
        vd[0 * VT_STRIDE] = (bf16)(vv.x & 0xffffu); vd[1 * VT_STRIDE] = (bf16)(vv.x >> 16);
        vd[2 * VT_STRIDE] = (bf16)(vv.y & 0xffffu); vd[3 * VT_STRIDE] = (bf16)(vv.y >> 16);
        vd[4 * VT_STRIDE] = (bf16)(vv.z & 0xffffu); vd[5 * VT_STRIDE] = (bf16)(vv.z >> 16);
        vd[6 * VT_STRIDE] = (bf16)(vv.w & 0xffffu); vd[7 * VT_STRIDE] = (bf16)(vv.w >> 16);
    }
    const int g = F.wave >> 1, head = hk * 4 + g;
    const float sink2 = sinks[head] * LOG2E;
    bf16x8 qfa[2][4];
#pragma unroll
    for (int qq = 0; qq < 2; ++qq) { const size_t qrow = (size_t)b * SEQ + nb * 128 + 32 * (2 * (F.wave & 1) + qq) + r;
#pragma unroll
        for (int ks = 0; ks < 4; ++ks) qfa[qq][ks] = *(const bf16x8*)(PROJ + qrow * INW + C_Q + head * 64 + 16 * ks + 8 * h); }
    __syncthreads();
#pragma unroll 1
    for (int qq = 0; qq < 2; ++qq) {
        const int qt = 2 * (F.wave & 1) + qq, i0 = 32 * qt;
        bf16x8 qf[4];
#pragma unroll
        for (int ks = 0; ks < 4; ++ks) qf[ks] = qq ? qfa[1][ks] : qfa[0][ks];
        const size_t qrow = (size_t)b * SEQ + nb * 128 + i0 + r;
        f32x16 s[5];
#pragma unroll
        for (int kt = 0; kt < 5; ++kt) {
            f32x16 a = {};
#pragma unroll
            for (int ks = 0; ks < 4; ++ks) { const bf16x8 kf = *(const LAS bf16x8*)(Ks + (32 * (qt + kt) + r) * KS_STRIDE + 16 * ks + 8 * h); a = MFMA32(kf, qf[ks], a); }
            s[kt] = a;
        }
        float mx = -1e30f;
#pragma unroll
        for (int kt = 0; kt < 5; ++kt) {
            const bool tile_ok = (nb > 0) || (qt + kt >= 4);
#pragma unroll
            for (int i = 0; i < 16; ++i) { const int jj = crow(i, h);
                bool valid = tile_ok; if (kt == 0) valid = valid && (jj > r); if (kt == 4) valid = valid && (jj <= r);
                const float v = valid ? s[kt][i] : -1e30f; s[kt][i] = v; mx = fmaxf(mx, v); }
        }
        constexpr float SC = 0.125f * LOG2E;
        mx = fmaxf(mx, lane_xor(mx, lane, 32)); mx = fmaxf(mx * SC, sink2);
        float sum = 0.f;
#pragma unroll
        for (int kt = 0; kt < 5; ++kt)
#pragma unroll
            for (int i = 0; i < 16; ++i) { const float p = __builtin_amdgcn_exp2f(__builtin_fmaf(s[kt][i], SC, -mx)); s[kt][i] = p; sum += p; }
        sum += lane_xor(sum, lane, 32); sum += __builtin_amdgcn_exp2f(sink2 - mx);
        const float inv = 1.0f / sum;
        f32x16 o[2] = {{}, {}};
#pragma unroll
        for (int kt = 0; kt < 5; ++kt)
#pragma unroll
            for (int st = 0; st < 2; ++st) {
                v4u pw; pw.x = pk2(s[kt][8 * st + 0], s[kt][8 * st + 1]); pw.y = pk2(s[kt][8 * st + 2], s[kt][8 * st + 3]);
                pw.z = pk2(s[kt][8 * st + 4], s[kt][8 * st + 5]); pw.w = pk2(s[kt][8 * st + 6], s[kt][8 * st + 7]);
                const bf16x8 pb = __builtin_bit_cast(bf16x8, pw);
#pragma unroll
                for (int db = 0; db < 2; ++db) {
                    const LAS bf16* vp = Vt + (32 * db + r) * VT_STRIDE + 32 * (qt + kt) + 16 * st + 4 * h;
                    const s16x4 lo = *(const LAS s16x4*)vp, hi = *(const LAS s16x4*)(vp + 8);
                    const bf16x8 va = __builtin_shufflevector(lo, hi, 0, 1, 2, 3, 4, 5, 6, 7);
                    o[db] = MFMA32(va, pb, o[db]);
                }
            }
        bf16* orow = MIX + qrow * D + 512 + head * 64;
#pragma unroll
        for (int db = 0; db < 2; ++db)
#pragma unroll
            for (int g4 = 0; g4 < 4; ++g4) { v2u w; w.x = pk2(o[db][4 * g4] * inv, o[db][4 * g4 + 1] * inv); w.y = pk2(o[db][4 * g4 + 2] * inv, o[db][4 * g4 + 3] * inv);
                *(v2u*)(orow + 32 * db + 8 * g4 + 4 * h) = w; }
    }
    __syncthreads();
}

constexpr int DL_STRIDE = 264, PC_TOK = 128, DL_OFF = (PC_TOK + 16) * DL_STRIDE * 2;
static_assert(DL_OFF + PC_TOK * DL_STRIDE * 2 <= MISC_OFF, "pool/conv LDS map");
__device__ __forceinline__ void pc_unit(Frame& F, int tok0, int l, const bf16* PROJ, bf16* MIX) {
    LAS bf16* Ul = (LAS bf16*)F.lds; LAS bf16* Dl = (LAS bf16*)(F.lds + DL_OFF);
    const int s0 = tok0 % SEQ;
    const float* cw = F.in[5] + (size_t)l * 3 * 256;
#pragma unroll
    for (int i = 0; i < 9; ++i) {
        const int idx = F.tid + 512 * i, rr = idx >> 5, ch = idx & 31;
        v4u w = (v4u){0u, 0u, 0u, 0u};
        if (s0 + rr - 16 >= 0) w = *(const v4u*)(PROJ + ((size_t)tok0 + rr - 16) * INW + ch * 8);
        *(LAS v4u*)(Ul + rr * DL_STRIDE + ch * 8) = w;
    }
#pragma unroll 4
    for (int i = 0; i < 8; ++i) {
        const int idx = F.tid + 512 * i, tk = idx >> 5, ch = idx & 31;
        const int s = s0 + tk; const size_t row = (size_t)tok0 + tk;
        float y[8];
#pragma unroll
        for (int e = 0; e < 8; ++e) y[e] = 0.f;
#pragma unroll
        for (int j = 0; j < 3; ++j) {
            if (s - 2 + j >= 0) { float gc[8], uc[8]; const bf16* p = PROJ + (row - 2 + j) * INW + ch * 8; ld8(p + C_GC, gc); ld8(p + C_UC, uc);
                const f32x4 wa = *(const f32x4*)(cw + j * 256 + ch * 8), wb = *(const f32x4*)(cw + j * 256 + ch * 8 + 4);
#pragma unroll
                for (int e = 0; e < 4; ++e) { y[e] += wa[e] * gc[e] * uc[e]; y[4 + e] += wb[e] * gc[4 + e] * uc[4 + e]; } }
        }
        float gb[8]; ld8(PROJ + row * INW + C_GB + ch * 8, gb);
        v4u ow; ow.x = pk2(gb[0] * y[0], gb[1] * y[1]); ow.y = pk2(gb[2] * y[2], gb[3] * y[3]); ow.z = pk2(gb[4] * y[4], gb[5] * y[5]); ow.w = pk2(gb[6] * y[6], gb[7] * y[7]);
        *(v4u*)(MIX + row * D + 256 + ch * 8) = ow;
    }
    __syncthreads();
#pragma unroll 1
    for (int i = 0; i < 8; ++i) {
        const int idx = F.tid + 512 * i, tk = idx >> 5, ch = idx & 31, grp = ch >> 3, w = 2 << grp;
        const int s = s0 + tk;
        float u[8], acc[8];
        { const v4u q = *(const LAS v4u*)(Ul + (tk + 16) * DL_STRIDE + ch * 8);
          u[0] = bf_lo(q.x); u[1] = bf_hi(q.x); u[2] = bf_lo(q.y); u[3] = bf_hi(q.y); u[4] = bf_lo(q.z); u[5] = bf_hi(q.z); u[6] = bf_lo(q.w); u[7] = bf_hi(q.w); }
#pragma unroll
        for (int e = 0; e < 8; ++e) acc[e] = u[e];
#pragma unroll
        for (int k = 1; k < 16; ++k) { if (k < w) { const v4u q = *(const LAS v4u*)(Ul + (tk + 16 - k) * DL_STRIDE + ch * 8);
            acc[0] += bf_lo(q.x); acc[1] += bf_hi(q.x); acc[2] += bf_lo(q.y); acc[3] += bf_hi(q.y); acc[4] += bf_lo(q.z); acc[5] += bf_hi(q.z); acc[6] += bf_lo(q.w); acc[7] += bf_hi(q.w); } }
        const int n = (s + 1 < w) ? s + 1 : w;
        const float rn = 1.0f / (float)n;
        v4u dw; dw.x = pk2(acc[0] * rn - u[0], acc[1] * rn - u[1]); dw.y = pk2(acc[2] * rn - u[2], acc[3] * rn - u[3]);
        dw.z = pk2(acc[4] * rn - u[4], acc[5] * rn - u[5]); dw.w = pk2(acc[6] * rn - u[6], acc[7] * rn - u[7]);
        *(LAS v4u*)(Dl + tk * DL_STRIDE + ch * 8) = dw;
    }
    __syncthreads();
    {
        const int lane = F.lane, r = lane & 31, h = lane >> 5, grp = F.wave >> 1;
        const bf16* PT = (const bf16*)(F.ws + WS_POOLT) + (size_t)(l * 4 + grp) * 4096;
        const float* psc = F.in[4] + (size_t)l * 256 + grp * 64;
        bf16x8 wf[2][4];
#pragma unroll
        for (int db = 0; db < 2; ++db)
#pragma unroll
            for (int ks = 0; ks < 4; ++ks) wf[db][ks] = *(const bf16x8*)(PT + (32 * db + r) * 64 + 16 * ks + 8 * h);
#pragma unroll 1
        for (int t2 = 0; t2 < 2; ++t2) {
            const int tt = 2 * (F.wave & 1) + t2;
            bf16x8 df[4];
#pragma unroll
            for (int ks = 0; ks < 4; ++ks) df[ks] = *(const LAS bf16x8*)(Dl + (32 * tt + r) * DL_STRIDE + 64 * grp + 16 * ks + 8 * h);
#pragma unroll
            for (int db = 0; db < 2; ++db) {
                f32x16 a = {};
#pragma unroll
                for (int ks = 0; ks < 4; ++ks) a = MFMA32(wf[db][ks], df[ks], a);
                bf16* orow = MIX + ((size_t)tok0 + 32 * tt + r) * D + grp * 64 + 32 * db;
#pragma unroll
                for (int g4 = 0; g4 < 4; ++g4) { const f32x4 sc = *(const f32x4*)(psc + 32 * db + 8 * g4 + 4 * h);
                    v2u w; w.x = pk2(a[4 * g4] * sc[0], a[4 * g4 + 1] * sc[1]); w.y = pk2(a[4 * g4 + 2] * sc[2], a[4 * g4 + 3] * sc[3]);
                    *(v2u*)(orow + 8 * g4 + 4 * h) = w; }
            }
        }
    }
    __syncthreads();
}

__device__ __forceinline__ void mixer_phase(Frame& F, int l) {
    const bf16* PROJ = (const bf16*)(F.ws + WS_PROJ); bf16* MIX = (bf16*)(F.ws + WS_MIX);
    const float* sinks = F.in[6] + l * 8;
    for (int u = F.bx; u < BATCH * 32 * 2; u += F.G) { const int hk = u & 1, nb = (u >> 1) & 31, b = u >> 6; attn_unit(F, b, nb, hk, PROJ, MIX, sinks); }
    for (int u = F.bx; u < M / PC_TOK; u += F.G) pc_unit(F, u * PC_TOK, l, PROJ, MIX);
}

__device__ __forceinline__ void fixup_phase(Frame& F, int l) {
    const float* head = (const float*)(F.ws + WS_HEAD); const float* tail = (const float*)(F.ws + WS_TAIL);
    const float* cw = F.in[11] + (size_t)l * 3 * UPW; const float* cb = F.in[12] + (size_t)l * UPW;
    bf16* H = (bf16*)(F.ws + WS_H);
    const int nth = F.G * NWAVES * 64;
    for (int idx = F.bx * (NWAVES * 64) + F.tid; idx < 128 * 2 * (FF / 4); idx += nth) {
        const int pm = idx / (2 * (FF / 4)), rem = idx % (2 * (FF / 4)), r = rem / (FF / 4), f = 4 * (rem % (FF / 4));
        if ((pm & 15) == 0) continue;
        f32x4 y[2];
#pragma unroll
        for (int hf = 0; hf < 2; ++hf) { const int c = hf * FF + f;
            const f32x4 cur = *(const f32x4*)(head + ((size_t)pm * 2 + r) * UPW + c);
            const f32x4 t0 = *(const f32x4*)(tail + ((size_t)(pm - 1) * 2 + 0) * UPW + c), t1 = *(const f32x4*)(tail + ((size_t)(pm - 1) * 2 + 1) * UPW + c);
            const f32x4 h0 = *(const f32x4*)(head + ((size_t)pm * 2 + 0) * UPW + c);
            const f32x4 p1 = r == 0 ? t1 : h0, p2 = r == 0 ? t0 : t1;
            const f32x4 w0 = *(const f32x4*)(cw + c), w1 = *(const f32x4*)(cw + UPW + c), w2 = *(const f32x4*)(cw + 2 * UPW + c), bb = *(const f32x4*)(cb + c);
            y[hf] = w2 * cur + w1 * p1 + w0 * p2 + bb; }
        float hv[4];
#pragma unroll
        for (int j = 0; j < 4; ++j) { const float g = y[0][j]; hv[j] = g * __builtin_amdgcn_rcpf(1.0f + __builtin_amdgcn_exp2f(-LOG2E * g)) * y[1][j]; }
        v2u w; w.x = pk2(hv[0], hv[1]); w.y = pk2(hv[2], hv[3]);
        *(v2u*)(H + ((size_t)pm * 256 + r) * FF + f) = w;
    }
}

#ifndef MK_MULTI
#define MK_MULTI 0
#endif
constexpr int N_PHASES = 1 + 8 * DEPTH;
struct Args { const float* in[15]; float* out; unsigned char* ws; int ph_lo, ph_hi; };
__global__ void __launch_bounds__(NWAVES * 64, 2) mk_fwd(const float* __restrict__ i0, const float* __restrict__ i1, const float* __restrict__ i2, const float* __restrict__ i3, const float* __restrict__ i4,
        const float* __restrict__ i5, const float* __restrict__ i6, const float* __restrict__ i7, const float* __restrict__ i8, const float* __restrict__ i9, const float* __restrict__ i10,
        const float* __restrict__ i11, const float* __restrict__ i12, const float* __restrict__ i13, const float* __restrict__ i14, float* out_p, unsigned char* ws_p, int ph_lo_p, int ph_hi_p) {
    Args args; args.in[0] = i0; args.in[1] = i1; args.in[2] = i2; args.in[3] = i3; args.in[4] = i4; args.in[5] = i5; args.in[6] = i6; args.in[7] = i7; args.in[8] = i8; args.in[9] = i9;
    args.in[10] = i10; args.in[11] = i11; args.in[12] = i12; args.in[13] = i13; args.in[14] = i14; args.out = out_p; args.ws = ws_p; args.ph_lo = ph_lo_p; args.ph_hi = ph_hi_p;
    extern __shared__ __attribute__((aligned(16))) unsigned char lds[];
    cg::grid_group grid = cg::this_grid();
    typedef __attribute__((address_space(1))) unsigned char gu8;
    int tid_c = threadIdx.x; gu8* ws_c = (gu8*)args.ws;
    volatile LAS unsigned* MISC = (volatile LAS unsigned*)((LAS unsigned char*)lds + MISC_OFF);
    if (threadIdx.x < 32) MISC[threadIdx.x] = 0u;
    __syncthreads();
    XcdBarrier bar; bar.bar = (unsigned*)(args.ws + WS_CTL); bar.x = 0; bar.st = nullptr;
    if (args.ph_hi - args.ph_lo > 1) bar = xcd_barrier_post((unsigned*)(args.ws + WS_CTL), MISC);
    for (int ph = args.ph_lo; ph < args.ph_hi; ++ph) {
        Frame F;
        asm volatile("" : "+v"(tid_c)); F.tid = tid_c;
        asm volatile("" : "+s"(ws_c)); F.ws = (unsigned char*)ws_c;
        F.lds = (LAS unsigned char*)lds;
        F.lane = F.tid & 63; F.wave = __builtin_amdgcn_readfirstlane(F.tid >> 6);
        F.G = gridDim.x; F.bx = blockIdx.x;
#pragma unroll
        for (int i = 0; i < 15; ++i) F.in[i] = args.in[i];
        F.out = args.out;
        bf16* XN = (bf16*)(F.ws + WS_XN); bf16* PROJ = (bf16*)(F.ws + WS_PROJ); bf16* MIX = (bf16*)(F.ws + WS_MIX); bf16* HB = (bf16*)(F.ws + WS_H); bf16* Y = (bf16*)(F.ws + WS_Y);
        if (ph == 0) { p0_prologue(F); }
        else {
            const int l = (ph - 1) >> 3, k = (ph - 1) & 7;
            unsigned char* wl = F.ws + WS_W + (size_t)l * W_LAYER;
            if (k == 0 || k == 2 || k == 6) {
                pg8::Gemm g; pg8::EpiBf16 E;
                if (k == 0) { g = pg8::Gemm{XN, (const bf16*)(wl + W_IN), M, INW, D}; E = pg8::EpiBf16{PROJ, INW, (const float*)(F.ws + WS_RSTD)}; }
                else if (k == 2) { g = pg8::Gemm{MIX, (const bf16*)(wl + W_O), M, D, D}; E = pg8::EpiBf16{Y, D}; }
                else { g = pg8::Gemm{HB, (const bf16*)(wl + W_DN), M, D, FF}; E = pg8::EpiBf16{Y, D, nullptr}; }
                pg8::StaticOrder S; S.init(M, g.N, F.G, F.bx);
                pg8::gemm_phase<pg8::EpiBf16, pg8::StaticOrder, true, true>(F.lds, g, S, E, F.tid);
            } else if (k == 1) {
                mixer_phase(F, l);
            } else if (k == 3 || k == 7) {
                const float* gain = (k == 3 ? F.in[8] : F.in[14]) + (size_t)l * D;
                post_rows(F, Y, XN, gain, (float*)(F.ws + WS_RSTD), (k == 7 && l == DEPTH - 1) ? F.out : (float*)nullptr);
            } else if (k == 4) {
                pg8::Gemm g{XN, (const bf16*)(wl + W_UP), M, UPW, D};
                pg8::EpiUpConv E{HB, F.in[11] + (size_t)l * 3 * UPW, F.in[12] + (size_t)l * UPW, (float*)(F.ws + WS_HEAD), (float*)(F.ws + WS_TAIL), (PG8_LAS float*)(F.lds + BND_OFF), (const float*)(F.ws + WS_RSTD)};
                pg8::StaticOrder S; S.init(M, UPW, F.G, F.bx);
                pg8::gemm_phase<pg8::EpiUpConv, pg8::StaticOrder, true, true>(F.lds, g, S, E, F.tid);
            } else {
                fixup_phase(F, l);
            }
        }
        if (ph + 1 < args.ph_hi) { if (args.ph_hi > 100000) grid.sync(); else xcd_barrier(bar); }
    }
}

extern "C" void kernel_launch(void* const* d_in, const int* in_sizes, int n_in, void* d_out, int out_size, void* d_ws, size_t ws_size, hipStream_t stream) {
    static int grid = 0;
    if (grid == 0) {
        if (n_in != 15 || out_size != M * D || ws_size < WS_END) { fprintf(stderr, "kernel_launch: unexpected problem (n_in %d, out %d, ws %zu); nothing launched\n", n_in, out_size, ws_size); grid = -1; return; }
        int dev = 0, cus = 0, per_cu = 0;
        if (hipGetDevice(&dev) != hipSuccess || hipDeviceGetAttribute(&cus, hipDeviceAttributeMultiprocessorCount, dev) != hipSuccess) { grid = -1; return; }
        if (hipFuncSetAttribute((const void*)mk_fwd, hipFuncAttributeMaxDynamicSharedMemorySize, LDS_BYTES) != hipSuccess) { fprintf(stderr, "kernel_launch: hipFuncSetAttribute failed\n"); grid = -1; return; }
        if (hipOccupancyMaxActiveBlocksPerMultiprocessor(&per_cu, (const void*)mk_fwd, NWAVES * 64, LDS_BYTES) != hipSuccess || per_cu < 1) { fprintf(stderr, "kernel_launch: occupancy query says %d\n", per_cu); per_cu = 1; }
        (void)hipGetLastError();
        grid = cus * per_cu;
    }
    if (grid < 0) return;
    if (hipMemsetAsync((char*)d_ws + WS_CTL, 0, CTL_ZERO_BYTES, stream) != hipSuccess) { fprintf(stderr, "kernel_launch: memset failed\n"); return; }
    Args a{};
    for (int i = 0; i < 15; ++i) a.in[i] = (const float*)d_in[i];
    a.out = (float*)d_out; a.ws = (unsigned char*)d_ws;
#if MK_MULTI
    for (int ph = 0; ph < N_PHASES; ++ph) { a.ph_lo = ph; a.ph_hi = ph + 1; hipLaunchKernelGGL(mk_fwd, dim3(grid), dim3(NWAVES * 64), LDS_BYTES, stream, a.in[0], a.in[1], a.in[2], a.in[3], a.in[4], a.in[5], a.in[6], a.in[7], a.in[8], a.in[9], a.in[10], a.in[11], a.in[12], a.in[13], a.in[14], a.out, a.ws, a.ph_lo, a.ph_hi); }
#else
    a.ph_lo = 0; a.ph_hi = N_PHASES;
    void* kargs[] = {&a.in[0], &a.in[1], &a.in[2], &a.in[3], &a.in[4], &a.in[5], &a.in[6], &a.in[7], &a.in[8], &a.in[9], &a.in[10], &a.in[11], &a.in[12], &a.in[13], &a.in[14], &a.out, &a.ws, &a.ph_lo, &a.ph_hi};
    hipError_t e = hipLaunchCooperativeKernel((const void*)mk_fwd, dim3(grid), dim3(NWAVES * 64), kargs, LDS_BYTES, stream);
    if (e != hipSuccess) fprintf(stderr, "kernel_launch: cooperative launch failed: %s (grid %d)\n", hipGetErrorString(e), grid);
#endif
}
```
